# Optimizing an MI355X kernel written in HIP

```python
import jax, jax.numpy as jnp
from jax import lax
import numpy as np

D_MODEL = 2048
BATCH = 4
SEQ = 4096
DEPTH = 4

N_MIXERS = 2
D_FF = 5632
SWA_HEAD_DIM = 64
SWA_HEADS = D_MODEL // SWA_HEAD_DIM
SWA_KV_HEADS = SWA_HEADS // 8
SWA_WINDOW = 128
SWA_IN = (SWA_HEADS + 2 * SWA_KV_HEADS) * SWA_HEAD_DIM
NSA_HEAD_DIM = 128
NSA_HEADS = D_MODEL // NSA_HEAD_DIM
NSA_KV_HEADS = 4
CMP_BLOCK = 32
CMP_STRIDE = 16
CMP_HIDDEN = 2 * NSA_HEAD_DIM
SLC_BLOCK = 64
SLC_TOP_N = 16
NSA_WINDOW = 512
NSA_IN = NSA_HEADS * NSA_HEAD_DIM + 6 * NSA_KV_HEADS * NSA_HEAD_DIM + 3 * NSA_HEADS
ATTN_BLOCK = 128
SEL_CHUNK = 32
ROPE_THETA = 500000.0
ROPE_FRACTION = 4
NORM_EPS = 1e-6
NEG_INF = -1e30
FORCE_SCORE = 1e9
TINY = 1e-30
MAX_START_POS = 1024

kernel_name = "hybrid_swa_sink_nsa_macaron"


def rms_norm(x, g):
    xf = x.astype(jnp.float32)
    y = xf * lax.rsqrt(jnp.mean(xf * xf, axis=-1, keepdims=True) + NORM_EPS)
    return (y * g).astype(x.dtype)


def partial_rope(x, pos):
    d = x.shape[-1]
    rd = d // ROPE_FRACTION
    half = rd // 2
    inv = 1.0 / (ROPE_THETA ** (jnp.arange(half, dtype=jnp.float32) * (2.0 / rd)))
    ang = pos.astype(jnp.float32)[..., None] * inv
    ang = ang.reshape(ang.shape[:2] + (1,) * (x.ndim - 3) + (half,))
    cos, sin = jnp.cos(ang), jnp.sin(ang)
    x1, x2, rest = x[..., :half], x[..., half:rd], x[..., rd:]
    rot = jnp.concatenate([x1 * cos - x2 * sin, x2 * cos + x1 * sin], axis=-1).astype(x.dtype)
    return jnp.concatenate([rot, rest], axis=-1)


def swiglu(x, w_in, w_out):
    gate, up = jnp.split(x @ w_in, 2, axis=-1)
    return (jax.nn.silu(gate) * up) @ w_out


def banded_attention(q, k, v, window, sinks=None):
    B, T, G, R, d = q.shape
    nb = T // ATTN_BLOCK
    P = window // ATTN_BLOCK
    qb = q.reshape(B, nb, ATTN_BLOCK, G, R, d)
    pad = ((0, 0), (P, 0), (0, 0), (0, 0), (0, 0))
    kb = jnp.pad(k.reshape(B, nb, ATTN_BLOCK, G, d), pad)
    vb = jnp.pad(v.reshape(B, nb, ATTN_BLOCK, G, d), pad)
    kw = jnp.concatenate([kb[:, s:s + nb] for s in range(P + 1)], axis=2)
    vw = jnp.concatenate([vb[:, s:s + nb] for s in range(P + 1)], axis=2)
    s = jnp.einsum('bnqgrd,bnkgd->bgrnqk', qb, kw).astype(jnp.float32) * (d ** -0.5)
    qi = jnp.arange(ATTN_BLOCK)[:, None]
    ki = jnp.arange((P + 1) * ATTN_BLOCK)[None, :]
    rel = qi + P * ATTN_BLOCK - ki
    kpos = jnp.arange(nb)[:, None, None] * ATTN_BLOCK - P * ATTN_BLOCK + ki
    mask = (rel >= 0) & (rel < window) & (kpos >= 0)
    s = jnp.where(mask, s, NEG_INF)
    if sinks is None:
        p = jax.nn.softmax(s, axis=-1)
    else:
        sink_col = jnp.broadcast_to(sinks.astype(jnp.float32)[:, :, None, None, None], s.shape[:-1] + (1,))
        p = jax.nn.softmax(jnp.concatenate([s, sink_col], axis=-1), axis=-1)[..., :-1]
    o = jnp.einsum('bgrnqk,bnkgd->bnqgrd', p.astype(v.dtype), vw)
    return o.reshape(B, T, G, R, d)


def swa_mixer(x, positions, w_in, q_norm, k_norm, sinks, w_out):
    B, T, _ = x.shape
    G, d = SWA_KV_HEADS, SWA_HEAD_DIM
    R = SWA_HEADS // G
    q, k, v = jnp.split(x @ w_in, [SWA_HEADS * d, (SWA_HEADS + G) * d], axis=-1)
    q = partial_rope(rms_norm(q.reshape(B, T, G, R, d), q_norm), positions)
    k = partial_rope(rms_norm(k.reshape(B, T, G, d), k_norm), positions)
    o = banded_attention(q, k, v.reshape(B, T, G, d), SWA_WINDOW, sinks.reshape(G, R))
    return o.reshape(B, T, SWA_HEADS * d) @ w_out


def compress(t, pe, w1, w2, idx):
    blocks = t[:, idx] + pe[:, None, :]
    hdn = jax.nn.silu(jnp.einsum('bnlgd,ldh->bngh', blocks, w1))
    return jnp.einsum('bngh,hd->bngd', hdn, w2)


def compressed_attention(q, k, v, positions, k_norm, pe_k, w1_k, w2_k, pe_v, w1_v, w2_v):
    B, T, G, R, d = q.shape
    n_cmp = (T - CMP_BLOCK) // CMP_STRIDE + 1
    starts = jnp.arange(n_cmp) * CMP_STRIDE
    idx = starts[:, None] + jnp.arange(CMP_BLOCK)[None, :]
    end_idx = starts + CMP_BLOCK - 1
    k_c = partial_rope(rms_norm(compress(k, pe_k, w1_k, w2_k, idx), k_norm), positions[:, end_idx])
    v_c = compress(v, pe_v, w1_v, w2_v, idx)
    s = jnp.einsum('btgrd,bngd->bgrtn', q, k_c).astype(jnp.float32) * (d ** -0.5)
    mask = end_idx[None, :] <= jnp.arange(T)[:, None]
    s = jnp.where(mask, s, NEG_INF)
    e = jnp.exp(s - jnp.max(s, axis=-1, keepdims=True)) * mask
    p = e / jnp.maximum(jnp.sum(e, axis=-1, keepdims=True), TINY)
    o = jnp.einsum('bgrtn,bngd->btgrd', p.astype(v.dtype), v_c)
    return o, p


def select_blocks(p_cmp, T):
    n_cmp = p_cmp.shape[-1]
    n_slc = T // SLC_BLOCK
    cs = jnp.arange(n_cmp)[:, None] * CMP_STRIDE
    ss = jnp.arange(n_slc)[None, :] * SLC_BLOCK
    overlap = ((cs < ss + SLC_BLOCK) & (cs + CMP_BLOCK > ss)).astype(jnp.float32)
    imp = jnp.einsum('bgrtn,nj->bgtj', p_cmp, overlap)
    t = jnp.arange(T)[:, None]
    j = jnp.arange(n_slc)[None, :]
    cur = t // SLC_BLOCK
    forced = (j == 0) | (j == cur) | (j == cur - 1)
    imp = jnp.where(forced, FORCE_SCORE, jnp.where(j * SLC_BLOCK <= t, imp, NEG_INF))
    _, idx = lax.top_k(imp, min(SLC_TOP_N, n_slc))
    return idx.transpose(0, 2, 1, 3)


def selected_attention(q, k, v, blk_idx):
    B, T, G, R, d = q.shape
    n_slc = T // SLC_BLOCK
    n_top = blk_idx.shape[-1]
    kb = k.reshape(B, n_slc, SLC_BLOCK, G, d).transpose(0, 3, 1, 2, 4)
    vb = v.reshape(B, n_slc, SLC_BLOCK, G, d).transpose(0, 3, 1, 2, 4)
    nc = T // SEL_CHUNK
    qc = q.reshape(B, nc, SEL_CHUNK, G, R, d).transpose(1, 0, 2, 3, 4, 5)
    ic = blk_idx.reshape(B, nc, SEL_CHUNK, G, n_top).transpose(1, 0, 2, 3, 4)
    tc = jnp.arange(T).reshape(nc, SEL_CHUNK)
    b_ix = jnp.arange(B)[:, None, None, None]
    g_ix = jnp.arange(G)[None, None, :, None]

    def chunk(args):
        q_, i_, t_ = args
        k_sel = kb[b_ix, g_ix, i_]
        v_sel = vb[b_ix, g_ix, i_]
        s = jnp.einsum('bcgrd,bcgnld->bcgrnl', q_, k_sel).astype(jnp.float32) * (d ** -0.5)
        kpos = i_[..., None] * SLC_BLOCK + jnp.arange(SLC_BLOCK)
        mask = (kpos <= t_[None, :, None, None, None])[:, :, :, None]
        s = jnp.where(mask, s, NEG_INF)
        p = jax.nn.softmax(s.reshape(s.shape[:4] + (n_top * SLC_BLOCK,)), axis=-1).reshape(s.shape)
        return jnp.einsum('bcgrnl,bcgnld->bcgrd', p.astype(v.dtype), v_sel)

    o = lax.map(chunk, (qc, ic, tc))
    return o.transpose(1, 0, 2, 3, 4, 5).reshape(B, T, G, R, d)


def nsa_mixer(x, positions, w_in, q_norm, k_norm, pe_k, w1_k, w2_k, pe_v, w1_v, w2_v, w_out):
    B, T, _ = x.shape
    H, G, d = NSA_HEADS, NSA_KV_HEADS, NSA_HEAD_DIM
    R = H // G
    splits = np.cumsum([H * d] + [G * d] * 6).tolist()
    q, kc, vc, ks, vs, kw, vw, gates = jnp.split(x @ w_in, splits, axis=-1)
    q = partial_rope(rms_norm(q.reshape(B, T, G, R, d), q_norm), positions)
    kc, vc, ks, vs, kw, vw = [t.reshape(B, T, G, d) for t in (kc, vc, ks, vs, kw, vw)]
    o_cmp, p_cmp = compressed_attention(q, kc, vc, positions, k_norm, pe_k, w1_k, w2_k, pe_v, w1_v, w2_v)
    ks = partial_rope(rms_norm(ks, k_norm), positions)
    o_slc = selected_attention(q, ks, vs, select_blocks(p_cmp, T))
    kw = partial_rope(rms_norm(kw, k_norm), positions)
    o_win = banded_attention(q, kw, vw, NSA_WINDOW)
    g = jax.nn.sigmoid(gates.reshape(B, T, 3, G, R))[..., None]
    o = g[:, :, 0] * o_cmp + g[:, :, 1] * o_slc + g[:, :, 2] * o_win
    return o.reshape(B, T, H * d) @ w_out


def setup_inputs(seed: int = 0) -> dict:
    key = jax.random.key(seed)
    k = jax.random.split(key, 24)
    n_swa = len(range(0, DEPTH, N_MIXERS))
    n_nsa = len(range(1, DEPTH, N_MIXERS))

    def dense(kk, shape, fan_in):
        return jax.random.normal(kk, shape, jnp.float32) * (fan_in ** -0.5)

    def gain(kk, shape):
        return 1.0 + 0.02 * jax.random.normal(kk, shape, jnp.float32)

    hd = NSA_HEAD_DIM
    x = jax.random.normal(k[0], (BATCH, SEQ, D_MODEL), jnp.float32)
    positions = (jax.random.randint(k[1], (BATCH, 1), 0, MAX_START_POS, dtype=jnp.int32)
                 + jnp.arange(SEQ, dtype=jnp.int32)[None, :])
    return {
        'x': x,
        'positions': positions,
        'ffn1_norm': gain(k[2], (DEPTH, D_MODEL)),
        'ffn1_w_in': dense(k[3], (DEPTH, D_MODEL, 2 * D_FF), D_MODEL),
        'ffn1_w_out': dense(k[4], (DEPTH, D_FF, D_MODEL), D_FF),
        'mix_norm': gain(k[5], (DEPTH, D_MODEL)),
        'ffn2_norm': gain(k[6], (DEPTH, D_MODEL)),
        'ffn2_w_in': dense(k[7], (DEPTH, D_MODEL, 2 * D_FF), D_MODEL),
        'ffn2_w_out': dense(k[8], (DEPTH, D_FF, D_MODEL), D_FF),
        'swa_w_in': dense(k[9], (n_swa, D_MODEL, SWA_IN), D_MODEL),
        'swa_q_norm': gain(k[10], (n_swa, SWA_HEAD_DIM)),
        'swa_k_norm': gain(k[11], (n_swa, SWA_HEAD_DIM)),
        'swa_sinks': jax.random.normal(k[12], (n_swa, SWA_HEADS), jnp.float32),
        'swa_w_out': dense(k[13], (n_swa, SWA_HEADS * SWA_HEAD_DIM, D_MODEL), SWA_HEADS * SWA_HEAD_DIM),
        'nsa_w_in': dense(k[14], (n_nsa, D_MODEL, NSA_IN), D_MODEL),
        'nsa_q_norm': gain(k[15], (n_nsa, hd)),
        'nsa_k_norm': gain(k[16], (n_nsa, hd)),
        'nsa_cmp_pe_k': 0.1 * jax.random.normal(k[17], (n_nsa, CMP_BLOCK, hd), jnp.float32),
        'nsa_cmp_w1_k': dense(k[18], (n_nsa, CMP_BLOCK, hd, CMP_HIDDEN), CMP_BLOCK * hd),
        'nsa_cmp_w2_k': dense(k[19], (n_nsa, CMP_HIDDEN, hd), CMP_HIDDEN),
        'nsa_cmp_pe_v': 0.1 * jax.random.normal(k[20], (n_nsa, CMP_BLOCK, hd), jnp.float32),
        'nsa_cmp_w1_v': dense(k[21], (n_nsa, CMP_BLOCK, hd, CMP_HIDDEN), CMP_BLOCK * hd),
        'nsa_cmp_w2_v': dense(k[22], (n_nsa, CMP_HIDDEN, hd), CMP_HIDDEN),
        'nsa_w_out': dense(k[23], (n_nsa, NSA_HEADS * hd, D_MODEL), NSA_HEADS * hd),
    }


def reference(x, positions, ffn1_norm, ffn1_w_in, ffn1_w_out, mix_norm, ffn2_norm, ffn2_w_in, ffn2_w_out,
              swa_w_in, swa_q_norm, swa_k_norm, swa_sinks, swa_w_out,
              nsa_w_in, nsa_q_norm, nsa_k_norm, nsa_cmp_pe_k, nsa_cmp_w1_k, nsa_cmp_w2_k,
              nsa_cmp_pe_v, nsa_cmp_w1_v, nsa_cmp_w2_v, nsa_w_out):
    h = x
    for i in range(DEPTH):
        h = h + 0.5 * swiglu(rms_norm(h, ffn1_norm[i]), ffn1_w_in[i], ffn1_w_out[i])
        hn = rms_norm(h, mix_norm[i])
        j = i // N_MIXERS
        if i % N_MIXERS == 0:
            h = h + swa_mixer(hn, positions, swa_w_in[j], swa_q_norm[j], swa_k_norm[j], swa_sinks[j], swa_w_out[j])
        else:
            h = h + nsa_mixer(hn, positions, nsa_w_in[j], nsa_q_norm[j], nsa_k_norm[j],
                              nsa_cmp_pe_k[j], nsa_cmp_w1_k[j], nsa_cmp_w2_k[j],
                              nsa_cmp_pe_v[j], nsa_cmp_w1_v[j], nsa_cmp_w2_v[j], nsa_w_out[j])
        h = h + 0.5 * swiglu(rms_norm(h, ffn2_norm[i]), ffn2_w_in[i], ffn2_w_out[i])
    return h
```

```cpp
#include <hip/hip_runtime.h>
#include <cstdio>
#include <cstdint>

#define DI __device__ __forceinline__
#define GAS __attribute__((address_space(1)))
#define LAS __attribute__((address_space(3)))

#ifndef RES_LO
#define RES_LO 0
#endif
#ifndef NSTAGES
#define NSTAGES 12
#endif

typedef unsigned short bf16_t;
typedef short bf16x8 __attribute__((ext_vector_type(8)));
typedef short s16x4 __attribute__((ext_vector_type(4)));
typedef float f32x4 __attribute__((ext_vector_type(4)));
typedef float f32x2 __attribute__((ext_vector_type(2)));
typedef float f32x16 __attribute__((ext_vector_type(16)));
typedef unsigned u32x4 __attribute__((ext_vector_type(4)));
typedef unsigned u32x2 __attribute__((ext_vector_type(2)));

constexpr int NB = 4, T = 4096, DM = 2048, M = NB * T, DFF = 5632, NFF = 2 * DFF, DEPTH = 4;
constexpr int SW_N = 2560;
constexpr int NS_NREAL = 5168, NS_N = 5120;
constexpr int NS_KC = 2048, NS_VC = 2560, NS_KS = 3072, NS_VS = 3584, NS_KW = 4096, NS_VW = 4608;
constexpr float EPS = 1e-6f;

constexpr size_t MiB = 1u << 20;
constexpr size_t al(size_t x) { return (x + MiB - 1) / MiB * MiB; }
constexpr size_t WS_CTL = 0, CTL_ZERO_BYTES = 32768;
constexpr size_t SZ_WFI = (size_t)NFF * DM * 2, SZ_WFO = (size_t)DM * DFF * 2, SZ_WSI = (size_t)SW_N * DM * 2, SZ_WO = (size_t)DM * DM * 2, SZ_WNI = (size_t)NS_N * DM * 2;
constexpr size_t SZ_W1 = (size_t)256 * 4096 * 2, SZ_W2 = (size_t)128 * 256 * 2, SZ_BIASP = (size_t)32 * 256 * 4;
constexpr size_t WS_WFI = 1 * MiB;
constexpr size_t WS_WFO = al(WS_WFI + 8 * SZ_WFI);
constexpr size_t WS_WSI = al(WS_WFO + 8 * SZ_WFO);
constexpr size_t WS_WSO = al(WS_WSI + 2 * SZ_WSI);
constexpr size_t WS_WNI = al(WS_WSO + 2 * SZ_WO);
constexpr size_t WS_WNO = al(WS_WNI + 2 * SZ_WNI);
constexpr size_t WS_W1 = al(WS_WNO + 2 * SZ_WO);
constexpr size_t WS_W2 = al(WS_W1 + 4 * SZ_W1);
constexpr size_t WS_BIASP = WS_W2 + 4 * SZ_W2;
constexpr size_t WS_ROPE64 = al(WS_BIASP + 4 * SZ_BIASP);
constexpr size_t WS_ROPE128 = al(WS_ROPE64 + (size_t)M * 16 * 4);
constexpr size_t WS_HB = al(WS_ROPE128 + (size_t)M * 32 * 4);
constexpr size_t WS_LB = al(WS_HB + (size_t)M * DM * 2);
constexpr size_t WS_ROWSS = al(WS_LB + (size_t)M * DM * 2);
constexpr size_t WS_ACT = al(WS_ROWSS + (size_t)M * 32 * 4);
constexpr size_t WS_OB = al(WS_ACT + (size_t)M * DFF * 2);
constexpr size_t WS_KC = al(WS_OB + (size_t)M * DM * 2);
constexpr size_t WS_VC = WS_KC + 1 * MiB;
constexpr size_t WS_WG = WS_VC + 1 * MiB;
constexpr size_t SZ_WG = (size_t)64 * DM * 2;
constexpr size_t WS_GATES = WS_WG + 1 * MiB;
constexpr size_t WS_END = WS_GATES + 4 * MiB;
static_assert((size_t)M * NS_N * 2 <= (size_t)M * DFF * 2, "nsa projections fit the activation region");

constexpr int CW_BAR = 4096;

constexpr int MISC_OFF = 154624;
constexpr int LDS_BYTES = 155648;
constexpr int NWAVES = 8;

DI unsigned cvtpk(float lo, float hi) { unsigned r; asm volatile("v_cvt_pk_bf16_f32 %0, %1, %2" : "=v"(r) : "v"(lo), "v"(hi)); return r; }
DI float bf2f(unsigned short b) { return __builtin_bit_cast(float, (unsigned)b << 16); }
DI float bflo(unsigned w) { return __builtin_bit_cast(float, w << 16); }
DI float bfhi(unsigned w) { return __builtin_bit_cast(float, w & 0xffff0000u); }
DI unsigned short f2bf1(float f) { return (unsigned short)(cvtpk(f, 0.f) & 0xffffu); }
DI float fast_rcp(float x) { return __builtin_amdgcn_rcpf(x); }
DI float fast_exp2(float x) { return __builtin_amdgcn_exp2f(x); }
DI float silu(float x) { return x * fast_rcp(1.f + fast_exp2(-1.4426950408889634f * x)); }
DI float sigmoidf_(float x) { return fast_rcp(1.f + fast_exp2(-1.4426950408889634f * x)); }
DI float sum_xor16(float s) { auto r = __builtin_amdgcn_permlane16_swap(__float_as_uint(s), __float_as_uint(s), false, false); return __uint_as_float(r[0]) + __uint_as_float(r[1]); }
DI float sum_xor32(float s) { auto r = __builtin_amdgcn_permlane32_swap(__float_as_uint(s), __float_as_uint(s), false, false); return __uint_as_float(r[0]) + __uint_as_float(r[1]); }
DI int lane_id_v() { int l; asm volatile("v_mbcnt_lo_u32_b32 %0, -1, 0\n\tv_mbcnt_hi_u32_b32 %0, -1, %0" : "=v"(l)); return l; }
#define LDS_WAIT() asm volatile("s_waitcnt lgkmcnt(0)" ::: "memory")
#define VM_WAIT() asm volatile("s_waitcnt vmcnt(0)" ::: "memory")

namespace pg8 {
constexpr int BM = 256, BK = 64, HALF = 128, HTB = HALF * BK * 2, STAGE_BYTES = 8 * HTB, NXCD = 8, WGM = 8;
__host__ __device__ __forceinline__ int lds_byte(int r, int c) { const int st = (r >> 4) * 2 + (c >> 5), rr = r & 15, cc = c & 31, ob = rr * 64 + cc * 2; return st * 1024 + (ob ^ (((ob >> 9) & 1) << 5)); }
__host__ __device__ __forceinline__ void stage_rc(int b, int& R, int& C) { const int st = b / 1024, sb = b % 1024, swz = sb ^ (((sb >> 9) & 1) << 5); R = (st >> 1) * 16 + swz / 64; C = (st & 1) * 32 + (swz % 64) / 2; }
__host__ __device__ __forceinline__ int perm32(int rho) { const int n = rho >> 4, i = rho & 15; return 8 * (i >> 2) + 4 * n + (i & 3); }
struct Unit { int pm, pn; };
struct Gemm { const bf16_t* A; const bf16_t* Bt; int M, N, K; };
struct StaticOrder {
    int nM, nN, nwg, G, c;
    __host__ __device__ void init(int M_, int N_, int G_, int c_) { nM = M_ / BM; nN = N_ / BM; nwg = nM * nN; G = G_; c = c_; }
    __host__ __device__ bool next(int i, Unit& u) const {
        const long L = (long)i * G + c; if (L >= nwg) return false;
        int wgid = (int)L; { const int q = nwg / NXCD, r = nwg % NXCD, xcd = wgid % NXCD, off = wgid / NXCD; wgid = (xcd < r ? xcd * (q + 1) : r * (q + 1) + (xcd - r) * q) + off; }
        const int nig = WGM * nN, gid = wgid / nig, fm = gid * WGM, gsz = (nM - fm) < WGM ? (nM - fm) : WGM;
        u.pm = fm + ((wgid % nig) % gsz); u.pn = (wgid % nig) / gsz; return true;
    }
    __device__ __forceinline__ void a_ready(const Unit&) const {}
    __device__ __forceinline__ void done(const Unit&) const {}
};

DI void load_rs(const float* rowss, int row0, int fq, float (&rs)[2][4]) {
    float a[2][4][8];
#pragma unroll
    for (int ai = 0; ai < 2; ++ai)
#pragma unroll
        for (int m = 0; m < 4; ++m)
#pragma unroll
            for (int q = 0; q < 8; ++q) a[ai][m][q] = ((const GAS float*)rowss)[(size_t)(fq * 8 + q) * M + row0 + ai * HALF + m * 16];
    asm volatile("" ::: "memory");
    float eps = EPS; asm volatile("" : "+v"(eps));
#pragma unroll
    for (int ai = 0; ai < 2; ++ai)
#pragma unroll
        for (int m = 0; m < 4; ++m) {
            float s = ((a[ai][m][0] + a[ai][m][1]) + (a[ai][m][2] + a[ai][m][3])) + ((a[ai][m][4] + a[ai][m][5]) + (a[ai][m][6] + a[ai][m][7]));
            s = sum_xor32(sum_xor16(s));
            rs[ai][m] = __builtin_amdgcn_rsqf(s * (1.0f / DM) + eps);
        }
}
constexpr int RSC_OFF = 131072, RSC_WAVE_BYTES = 1024;
DI void cached_rs(const float* rowss, int pm, int row0, int wid, int fr, int fq, float (&rs)[2][4]) {
    LAS float* slot = (LAS float*)(unsigned)(RSC_OFF + wid * RSC_WAVE_BYTES);
    const int tag = ((volatile LAS int*)slot)[0];
    if (__builtin_amdgcn_readfirstlane(tag) != pm) {
        load_rs(rowss, row0, fq, rs);
        if (fq == 0) {
#pragma unroll
            for (int ai = 0; ai < 2; ++ai)
#pragma unroll
                for (int m = 0; m < 4; ++m) slot[16 + 16 * (4 * ai + m) + fr] = rs[ai][m];
        }
        if (fq == 0 && fr == 0) ((volatile LAS int*)slot)[0] = pm;
    } else {
#pragma unroll
        for (int ai = 0; ai < 2; ++ai)
#pragma unroll
            for (int m = 0; m < 4; ++m) rs[ai][m] = slot[16 + 16 * (4 * ai + m) + fr];
    }
}
DI void cached_rs_reset(int wid) {
    if (lane_id_v() == 0) ((volatile LAS int*)(unsigned)(RSC_OFF + wid * RSC_WAVE_BYTES))[0] = -1;
}
struct EpiSwiGLU {
    static constexpr bool PERM = true, AFTER_DRAIN = false, WIDE = false;
    bf16_t* O; const float* rowss;
    DI void operator()(const f32x4 (&acc)[2][2][4][2], const Unit& u, int wr, int wc, int fr, int fq) const {
        const int row0 = u.pm * BM + wr * 64 + fr, col0 = u.pn * HALF + wc * 32 + 8 * fq;
        float rs[2][4]; cached_rs(rowss, u.pm, row0, wr * 4 + wc, fr, fq, rs);
#pragma unroll
        for (int ai = 0; ai < 2; ++ai)
#pragma unroll
            for (int m = 0; m < 4; ++m) {
                const float r = rs[ai][m], rn = -1.4426950408889634f * r, r2 = r * r;
                u32x4 w;
#pragma unroll
                for (int n = 0; n < 2; ++n)
#pragma unroll
                    for (int h2 = 0; h2 < 2; ++h2) {
                        const f32x2 g = {acc[ai][0][m][n][2 * h2], acc[ai][0][m][n][2 * h2 + 1]}, uu = {acc[ai][1][m][n][2 * h2], acc[ai][1][m][n][2 * h2 + 1]};
                        f32x2 t = g * rn; t = __builtin_elementwise_min(t, (f32x2){60.f, 60.f});
                        f32x2 d; d.x = fast_exp2(t.x); d.y = fast_exp2(t.y); d = d + 1.0f;
                        const float R = fast_rcp(d.x * d.y);
                        const f32x2 q = (f32x2){d.y, d.x} * R;
                        const f32x2 o = ((g * uu) * r2) * q;
                        const unsigned pk = cvtpk(o.x, o.y);
                        if (n == 0) { if (h2 == 0) w.x = pk; else w.y = pk; } else { if (h2 == 0) w.z = pk; else w.w = pk; }
                    }
                *(GAS u32x4*)(O + (size_t)(row0 + ai * HALF + m * 16) * DFF + col0) = w;
            }
    }
};
struct EpiScaleBf16 {
    static constexpr bool PERM = true, AFTER_DRAIN = false, WIDE = false;
    bf16_t* O; int ldc; const float* rowss;
    DI void operator()(const f32x4 (&acc)[2][2][4][2], const Unit& u, int wr, int wc, int fr, int fq) const {
        const int row0 = u.pm * BM + wr * 64 + fr, col0 = u.pn * BM + wc * 32 + 8 * fq;
        float rs[2][4]; cached_rs(rowss, u.pm, row0, wr * 4 + wc, fr, fq, rs);
#pragma unroll
        for (int ai = 0; ai < 2; ++ai)
#pragma unroll
            for (int m = 0; m < 4; ++m) {
                const float r = rs[ai][m]; bf16_t* rowp = O + (size_t)(row0 + ai * HALF + m * 16) * ldc + col0;
#pragma unroll
                for (int bj = 0; bj < 2; ++bj) { const f32x4 v0 = acc[ai][bj][m][0] * r, v1 = acc[ai][bj][m][1] * r;
                    u32x4 w; w.x = cvtpk(v0[0], v0[1]); w.y = cvtpk(v0[2], v0[3]); w.z = cvtpk(v1[0], v1[1]); w.w = cvtpk(v1[2], v1[3]);
                    *(GAS u32x4*)(rowp + bj * HALF) = w; }
            }
    }
};
struct EpiResid {
    static constexpr bool PERM = true, AFTER_DRAIN = false, WIDE = true;
    bf16_t* hi; bf16_t* lo; float* out; float* rowss; float scale;
    DI void operator()(const f32x4 (&acc)[2][2][4][2], const Unit& u, int wr, int wc, int fr, int fq) const {
        const int row0 = u.pm * BM + wr * 64 + fr, col0 = u.pn * BM + wc * 64 + 8 * fq;
        const size_t hbase = (size_t)u.pn * ((size_t)M * 256) + wc * 64 + 8 * fq;
        u32x4 H[2][4][2];
#pragma unroll
        for (int ai = 0; ai < 2; ++ai)
#pragma unroll
            for (int m = 0; m < 4; ++m)
#pragma unroll
                for (int bj = 0; bj < 2; ++bj) H[ai][m][bj] = *(const GAS u32x4*)(hi + hbase + (size_t)(row0 + ai * HALF + m * 16) * 256 + bj * 32);
        asm volatile("" ::: "memory");
#pragma unroll
        for (int ai = 0; ai < 2; ++ai) {
#pragma unroll
            for (int m = 0; m < 4; ++m) {
                const int r = row0 + ai * HALF + m * 16; const size_t off = (size_t)r * DM + col0; float ss = 0.f;
#pragma unroll
                for (int bj = 0; bj < 2; ++bj) {
                    const u32x4 h = H[ai][m][bj];
                    const f32x4 a0 = acc[ai][bj][m][0], a1 = acc[ai][bj][m][1];
                    float v[8];
                    v[0] = bflo(h.x) + a0[0] * scale; v[1] = bfhi(h.x) + a0[1] * scale;
                    v[2] = bflo(h.y) + a0[2] * scale; v[3] = bfhi(h.y) + a0[3] * scale;
                    v[4] = bflo(h.z) + a1[0] * scale; v[5] = bfhi(h.z) + a1[1] * scale;
                    v[6] = bflo(h.w) + a1[2] * scale; v[7] = bfhi(h.w) + a1[3] * scale;
#pragma unroll
                    for (int e = 0; e < 8; ++e) ss += v[e] * v[e];
                    u32x4 nh;
                    nh.x = cvtpk(v[0], v[1]); nh.y = cvtpk(v[2], v[3]); nh.z = cvtpk(v[4], v[5]); nh.w = cvtpk(v[6], v[7]);
                    *(GAS u32x4*)(hi + hbase + (size_t)r * 256 + bj * 32) = nh;
                    if (out) { *(GAS f32x4*)(out + off + bj * 32) = (f32x4){v[0], v[1], v[2], v[3]}; *(GAS f32x4*)(out + off + bj * 32 + 4) = (f32x4){v[4], v[5], v[6], v[7]}; }
                }
                ss = sum_xor32(sum_xor16(ss));
                if (fq == 0) ((GAS float*)rowss)[(size_t)(u.pn * 4 + wc) * M + r] = ss;
            }
        }
    }
};

template <class Epi, class Sched, int KC, bool ALIGN_EPI = false, bool SP2 = false, bool ATILED = false>
__device__ __forceinline__ void gemm_phase(LAS unsigned char* lds, const Gemm g, const Sched& S, const Epi& E, int wave_s) {
    int tid_ = wave_s * 64 + lane_id_v(); asm volatile("" : "+v"(tid_));
    const int tid = tid_, wid = __builtin_amdgcn_readfirstlane(tid >> 6), lane = tid & 63, wr = wid >> 2, wc = wid & 3, fr = lane & 15, fq = lane >> 4;
    constexpr int K = KC, nt = K / BK;
    unsigned voffA[2], voffB[2];
#pragma unroll
    for (int i = 0; i < 2; ++i) { int R, C; stage_rc(tid * 16 + i * 8192, R, C);
        const int Rb = Epi::WIDE ? (64 * (R >> 5) + perm32(R & 31)) : (Epi::PERM ? ((R & ~31) + perm32(R & 31)) : R);
        voffA[i] = ATILED ? (unsigned)(R * 256 + C) * 2u : (unsigned)(R * K + C) * 2u; voffB[i] = (unsigned)(Rb * K + C) * 2u; }
    const size_t kstep = (size_t)(BK * 2);
    const size_t hstep = (size_t)HALF * K * 2;
    const size_t hstepB = Epi::WIDE ? (size_t)32 * K * 2 : hstep;
    const size_t tstep = 2 * hstep;
    const size_t hstepA = ATILED ? (size_t)HALF * 512 : hstep, tstepA = 2 * hstepA;
    const size_t panelA = (size_t)g.M * 512;
#define PG8_AOFF(t_) (ATILED ? (size_t)((t_) >> 2) * panelA + (size_t)((t_) & 3) * kstep : (size_t)(t_) * kstep)
    const unsigned ldsw = (unsigned)wid * 1024u;
    const int aoff = lds_byte(wr * 64 + fr, fq * 8), boff = lds_byte(wc * 32 + fr, fq * 8);
#define PG8_SA(b, h) (((b) * 2 + (h)) * HTB)
#define PG8_SB(b, h) ((4 + (b) * 2 + (h)) * HTB)
#define PG8_STAGE(bufoff, gbase, voff) do { _Pragma("unroll") for (int _i = 0; _i < 2; ++_i) \
        __builtin_amdgcn_global_load_lds((const unsigned*)((const char*)(gbase) + (voff)[_i]), (LAS unsigned*)(lds + (bufoff) + ldsw + _i * 8192), 16, 0, 0); } while (0)
#define PG8_LDA(dst, b, h) do { _Pragma("unroll") for (int m = 0; m < 4; ++m) _Pragma("unroll") for (int k = 0; k < 2; ++k) dst[m][k] = *(const LAS bf16x8*)(lds + PG8_SA(b, h) + aoff + m * 2048 + k * 1024); } while (0)
#define PG8_LDB(dst, b, h) do { _Pragma("unroll") for (int n = 0; n < 2; ++n) _Pragma("unroll") for (int k = 0; k < 2; ++k) dst[n][k] = *(const LAS bf16x8*)(lds + PG8_SB(b, h) + boff + n * 2048 + k * 1024); } while (0)
#define PG8_MMA(ai, bj, At, Bt) do { __builtin_amdgcn_s_setprio(1); _Pragma("unroll") for (int m = 0; m < 4; ++m) _Pragma("unroll") for (int n = 0; n < 2; ++n) _Pragma("unroll") for (int k = 0; k < 2; ++k) \
        acc[ai][bj][m][n] = __builtin_amdgcn_mfma_f32_16x16x32_bf16(Bt[n][k], At[m][k], acc[ai][bj][m][n], 0, 0, 0); __builtin_amdgcn_s_setprio(0); } while (0)
#define PG8_WAIT_V(n) asm volatile("s_waitcnt vmcnt(" #n ")" ::: "memory")
#define PG8_WAIT_L(n) asm volatile("s_waitcnt lgkmcnt(" #n ")" ::: "memory")
#define PG8_BAR __builtin_amdgcn_s_barrier()
#define PG8_SCHED __builtin_amdgcn_sched_barrier(0)
    Unit cur, nxt; int ui = 0;
    if (!S.next(0, cur)) return;
    f32x4 acc[2][2][4][2];
#pragma unroll
    for (int a = 0; a < 2; ++a)
#pragma unroll
        for (int b = 0; b < 2; ++b)
#pragma unroll
            for (int m = 0; m < 4; ++m)
#pragma unroll
                for (int n = 0; n < 2; ++n) acc[a][b][m][n] = (f32x4){0.f, 0.f, 0.f, 0.f};
    bf16x8 At[4][2], B0[2][2], B1[2][2];
    const char* cA = (const char*)g.A + (size_t)cur.pm * tstepA; const char* cB = (const char*)g.Bt + (size_t)cur.pn * tstep;
    S.a_ready(cur);
    if constexpr (SP2) {
        PG8_STAGE(PG8_SB(0, 0), cB, voffB); PG8_STAGE(PG8_SB(0, 1), cB + hstepB, voffB); PG8_STAGE(PG8_SA(0, 0), cA, voffA); PG8_STAGE(PG8_SA(0, 1), cA + hstepA, voffA);
        if (wr == 1) PG8_BAR;
        PG8_WAIT_V(2); PG8_BAR;
        PG8_STAGE(PG8_SB(1, 0), cB + kstep, voffB); PG8_STAGE(PG8_SA(1, 0), cA + kstep, voffA); PG8_STAGE(PG8_SB(1, 1), cB + hstepB + kstep, voffB);
        PG8_WAIT_V(6); PG8_BAR;
    } else {
        PG8_STAGE(PG8_SB(0, 0), cB, voffB); PG8_STAGE(PG8_SA(0, 0), cA, voffA); PG8_STAGE(PG8_SB(0, 1), cB + hstepB, voffB); PG8_STAGE(PG8_SA(0, 1), cA + hstepA, voffA);
        if (wr == 1) PG8_BAR;
        PG8_WAIT_V(4); PG8_BAR;
        PG8_STAGE(PG8_SB(1, 0), cB + kstep, voffB); PG8_STAGE(PG8_SA(1, 0), cA + kstep, voffA); PG8_STAGE(PG8_SB(1, 1), cB + hstepB + kstep, voffB);
        PG8_WAIT_V(6); PG8_BAR;
    }
    for (;;) {
        const bool has_next = S.next(ui + 1, nxt);
        const char* nA = has_next ? (const char*)g.A + (size_t)nxt.pm * tstepA : cA; const char* nB = has_next ? (const char*)g.Bt + (size_t)nxt.pn * tstep : cB;
        for (int t = 0; t < nt; t += 2) {
            const bool last = (t == nt - 2);
            const char* a1 = cA + PG8_AOFF(t + 1);
            const char* a2 = last ? nA : cA + PG8_AOFF(t + 2); const char* b2 = last ? nB : cB + (size_t)(t + 2) * kstep;
            const char* a3 = a2 + kstep; const char* b3 = b2 + kstep;
            if (last && has_next) S.a_ready(nxt);
            if constexpr (SP2) {
            PG8_LDB(B0, 0, 0); PG8_LDB(B1, 0, 1); PG8_SCHED; PG8_LDA(At, 0, 0); PG8_STAGE(PG8_SA(1, 1), a1 + hstepA, voffA);
            PG8_WAIT_V(8); PG8_WAIT_L(0); PG8_BAR; PG8_MMA(0, 0, At, B0); PG8_MMA(0, 1, At, B1); PG8_BAR; PG8_SCHED;
            PG8_LDA(At, 0, 1); PG8_STAGE(PG8_SB(0, 0), b2, voffB); PG8_STAGE(PG8_SB(0, 1), b2 + hstepB, voffB); PG8_STAGE(PG8_SA(0, 0), a2, voffA);
            PG8_WAIT_V(8); PG8_WAIT_L(0); PG8_BAR; PG8_MMA(1, 0, At, B0); PG8_MMA(1, 1, At, B1); PG8_BAR; PG8_SCHED;
            PG8_LDB(B0, 1, 0); PG8_LDB(B1, 1, 1); PG8_SCHED; PG8_LDA(At, 1, 0); PG8_STAGE(PG8_SA(0, 1), a2 + hstepA, voffA);
            PG8_WAIT_V(8); PG8_WAIT_L(0); PG8_BAR; PG8_MMA(0, 0, At, B0); PG8_MMA(0, 1, At, B1); PG8_BAR; PG8_SCHED;
            PG8_LDA(At, 1, 1); PG8_STAGE(PG8_SB(1, 0), b3, voffB); PG8_STAGE(PG8_SB(1, 1), b3 + hstepB, voffB); PG8_STAGE(PG8_SA(1, 0), a3, voffA);
            PG8_WAIT_V(8); PG8_WAIT_L(0); PG8_BAR; PG8_MMA(1, 0, At, B0); PG8_MMA(1, 1, At, B1); PG8_BAR; PG8_SCHED;
            } else {
            PG8_LDB(B0, 0, 0); PG8_SCHED; PG8_LDA(At, 0, 0); PG8_STAGE(PG8_SA(1, 1), a1 + hstepA, voffA);
            PG8_WAIT_L(8); PG8_BAR; PG8_WAIT_L(0); PG8_MMA(0, 0, At, B0); PG8_BAR; PG8_SCHED;
            PG8_LDB(B1, 0, 1); PG8_STAGE(PG8_SB(0, 0), b2, voffB);
            PG8_BAR; PG8_WAIT_L(0); PG8_MMA(0, 1, At, B1); PG8_BAR;
            PG8_LDA(At, 0, 1); PG8_STAGE(PG8_SA(0, 0), a2, voffA);
            PG8_BAR; PG8_WAIT_L(0); PG8_MMA(1, 0, At, B0); PG8_BAR; PG8_SCHED;
            PG8_STAGE(PG8_SB(0, 1), b2 + hstepB, voffB);
            PG8_WAIT_V(6); PG8_BAR; PG8_MMA(1, 1, At, B1); PG8_BAR;
            PG8_LDB(B0, 1, 0); PG8_SCHED; PG8_LDA(At, 1, 0); PG8_STAGE(PG8_SA(0, 1), a2 + hstepA, voffA);
            PG8_WAIT_L(8); PG8_BAR; PG8_WAIT_L(0); PG8_MMA(0, 0, At, B0); PG8_BAR; PG8_SCHED;
            PG8_LDB(B1, 1, 1); PG8_STAGE(PG8_SB(1, 0), b3, voffB);
            PG8_BAR; PG8_WAIT_L(0); PG8_MMA(0, 1, At, B1); PG8_BAR;
            PG8_LDA(At, 1, 1); PG8_STAGE(PG8_SA(1, 0), a3, voffA);
            PG8_BAR; PG8_WAIT_L(0); PG8_MMA(1, 0, At, B0); PG8_BAR; PG8_SCHED;
            PG8_STAGE(PG8_SB(1, 1), b3 + hstepB, voffB);
            PG8_WAIT_V(6); PG8_BAR; PG8_MMA(1, 1, At, B1); PG8_BAR;
            }
        }
        if constexpr (ALIGN_EPI) { if (wr == 0) PG8_BAR; }
        if constexpr (!Epi::AFTER_DRAIN) { E(acc, cur, wr, wc, fr, fq); S.done(cur); }
        if (!has_next) break;
#pragma unroll
        for (int a = 0; a < 2; ++a)
#pragma unroll
            for (int b = 0; b < 2; ++b)
#pragma unroll
                for (int m = 0; m < 4; ++m)
#pragma unroll
                    for (int n = 0; n < 2; ++n) acc[a][b][m][n] = (f32x4){0.f, 0.f, 0.f, 0.f};
        cur = nxt; cA = nA; cB = nB; ++ui;
        if constexpr (ALIGN_EPI) { if (wr == 1) PG8_BAR; }
    }
    PG8_WAIT_V(0);
    if constexpr (!ALIGN_EPI) { if (wr == 0) PG8_BAR; }
    PG8_BAR;
#undef PG8_AOFF
#undef PG8_SA
#undef PG8_SB
#undef PG8_STAGE
#undef PG8_LDA
#undef PG8_LDB
#undef PG8_MMA
#undef PG8_WAIT_V
#undef PG8_WAIT_L
#undef PG8_BAR
#undef PG8_SCHED
}
}

#define XB_TMO      128
#define XB_XCNT(j)  (256  + 64 * (j))
#define XB_XSUB(j)  (1280 + 64 * (j))
#define XB_XGEN(j)  (2304 + 64 * (j))
#define XB_TOP      3328
#define XB_TOPGEN   3392
#define XCD_BAR_WORDS 3456
#define XB_SPIN_CAP (1u << 18)
__device__ __forceinline__ unsigned xb_ld(unsigned* p)              { return __hip_atomic_load(p, __ATOMIC_RELAXED, __HIP_MEMORY_SCOPE_AGENT); }
__device__ __forceinline__ unsigned xb_add(unsigned* p, unsigned v) { return __hip_atomic_fetch_add(p, v, __ATOMIC_RELAXED, __HIP_MEMORY_SCOPE_AGENT); }
__device__ __forceinline__ unsigned xb_xcc_id() { return (unsigned)__builtin_amdgcn_s_getreg((3 << 11) | 20) & 0xFu; }
#define XB_SPIN(cond, bar) do { unsigned _sp = 0; while (cond) { __builtin_amdgcn_s_sleep(1); \
    if ((++_sp & 255u) == 0u) { if (xb_ld(&(bar)[XB_TMO])) break; if (_sp > XB_SPIN_CAP) { atomicAdd(&(bar)[XB_TMO], 1u); break; } } } } while (0)
struct XcdBarrier { unsigned* bar; unsigned x; volatile LAS unsigned* st; };
__device__ __forceinline__ XcdBarrier xcd_barrier_post(unsigned* bar, volatile LAS unsigned* st) {
    XcdBarrier b; b.bar = bar; b.x = xb_xcc_id(); b.st = st;
    if (threadIdx.x == 0) (void)xb_add(&bar[XB_XCNT(b.x)], 1u);
    return b;
}
__device__ __forceinline__ void xcd_barrier_complete(unsigned* bar, unsigned x, unsigned& nloc, unsigned& nx) {
    const unsigned G = gridDim.x * gridDim.y * gridDim.z;
    unsigned sum, cnt, mine, sp = 0u;
    for (;;) {
        sum = 0u; cnt = 0u; mine = 0u;
#pragma unroll
        for (unsigned j = 0; j < 16; ++j) { const unsigned c = xb_ld(&bar[XB_XCNT(j)]); sum += c; cnt += (c > 0u) ? 1u : 0u; mine = (j == x) ? c : mine; }
        if (sum == G) break;
        __builtin_amdgcn_s_sleep(1);
        if ((++sp & 255u) == 0u) { if (xb_ld(&bar[XB_TMO])) break; if (sp > XB_SPIN_CAP) { atomicAdd(&bar[XB_TMO], 1u); break; } }
    }
    nloc = mine > 0u ? mine : 1u; nx = cnt > 0u ? cnt : 1u;
}
__device__ __forceinline__ void xcd_barrier(const XcdBarrier& b, bool thread0) {
    asm volatile("s_waitcnt vmcnt(0)" ::: "memory");
    __syncthreads();
    if (thread0) {
        unsigned* bar = b.bar;
        __builtin_amdgcn_s_waitcnt(0);
        unsigned nloc = b.st[0], nx = b.st[1];
        if (nloc == 0u) { xcd_barrier_complete(bar, b.x, nloc, nx); b.st[0] = nloc; b.st[1] = nx; }
        const unsigned old = xb_add(&bar[XB_XSUB(b.x)], 1u);
        const unsigned gen = old / nloc;
        if (old + 1u == (gen + 1u) * nloc) {
            __builtin_amdgcn_fence(__ATOMIC_RELEASE, "agent");
            asm volatile("s_waitcnt vmcnt(0)" ::: "memory");
            const unsigned og = xb_add(&bar[XB_TOP], 1u);
            const unsigned tg = og / nx;
            if (og + 1u == (tg + 1u) * nx) xb_add(&bar[XB_TOPGEN], 1u);
            else XB_SPIN(xb_ld(&bar[XB_TOPGEN]) == tg, bar);
            __builtin_amdgcn_fence(__ATOMIC_ACQUIRE, "agent");
            xb_add(&bar[XB_XGEN(b.x)], 1u);
            asm volatile("s_waitcnt vmcnt(0)" ::: "memory");
        } else {
            XB_SPIN(xb_ld(&bar[XB_XGEN(b.x)]) == gen, bar);
            __builtin_amdgcn_fence(__ATOMIC_ACQUIRE, "agent");
            asm volatile("s_waitcnt vmcnt(0)" ::: "memory");
        }
    }
    __syncthreads();
}

__device__ __forceinline__ void xcd_barrier_local(const XcdBarrier& b, bool thread0) {
    asm volatile("s_waitcnt vmcnt(0)" ::: "memory");
    __syncthreads();
    if (thread0) {
        unsigned* bar = b.bar;
        __builtin_amdgcn_s_waitcnt(0);
        const unsigned nloc = b.st[0];
        const unsigned old = xb_add(&bar[XB_XSUB(b.x)], 1u);
        const unsigned gen = old / nloc;
        if (old + 1u == (gen + 1u) * nloc) xb_add(&bar[XB_XGEN(b.x)], 1u);
        else XB_SPIN(xb_ld(&bar[XB_XGEN(b.x)]) == gen, bar);
        __builtin_amdgcn_fence(__ATOMIC_ACQUIRE, "agent");
        asm volatile("s_waitcnt vmcnt(0)" ::: "memory");
    }
    __syncthreads();
}

namespace att {
#define SBAR() __builtin_amdgcn_sched_barrier(0)
constexpr float NEGS = -1e30f;
constexpr float M_INIT = -30000.f;
DI int crow(int r, int hi) { return (r & 3) + 8 * (r >> 2) + 4 * hi; }
template <int D> DI int koff(int row, int cb) { return row * (2 * D) + (cb ^ ((row & 7) << 4)); }
template <int D> DI int v_st(int k, int c) { const int kk = (k & ~0xC) | ((k & 4) << 1) | ((k & 8) >> 1); return ((kk >> 3) * (D / 32) + (c >> 5)) * 512 + ((kk & 7) * 32 + (c & 31)) * 2; }
DI int v_rd_base(int lane) { return ((lane & 3) << 3) | (((lane >> 2) & 3) << 6) | (((lane >> 4) & 1) << 5) | (((lane >> 5) & 1) << 8); }
template <int D> constexpr int v_rd_off(int d0, int ks, int half) { return d0 * 512 + ks * (2 * (D / 32) * 512) + half * ((D / 32) * 512); }
template <int OFF> DI s16x4 tr_read(int vb) { s16x4 r; asm volatile("ds_read_b64_tr_b16 %0, %1 offset:%2" : "=&v"(r) : "v"(vb), "i"(OFF) : "memory"); return r; }

template <int D> struct Core {
    float m_reg, l_reg; f32x16 o[D / 32]; bf16x8 qr[D / 16];
};
template <int D> DI void core_reset(Core<D>& c, float m0, float l0) {
    c.m_reg = m0; c.l_reg = l0;
#pragma unroll
    for (int d = 0; d < D / 32; ++d)
#pragma unroll
        for (int r = 0; r < 16; ++r) c.o[d][r] = 0.f;
}
template <int D> DI void load_q(Core<D>& c, const bf16_t* qrow, int hi) {
#pragma unroll
    for (int d0 = 0; d0 < D / 16; ++d0) c.qr[d0] = *(const GAS bf16x8*)(qrow + d0 * 16 + hi * 8);
}
template <int D, int NBT = 4> DI void qkt(f32x16& p0, f32x16& p1, const char* Ks, const bf16x8* qr, int r32, int hi) {
#pragma unroll
    for (int r = 0; r < 16; ++r) { p0[r] = 0.f; p1[r] = 0.f; }
    int rowb = r32 * (2 * D), swz = (r32 & 7) << 4; asm volatile("" : "+v"(rowb), "+v"(swz));
#pragma unroll
    for (int g4 = 0; g4 < D / (16 * NBT); ++g4) {
        bf16x8 kf[2 * NBT];
#pragma unroll
        for (int i = 0; i < NBT; ++i) { const int cb = ((g4 * NBT + i) * 16 + hi * 8) * 2;
            const char* kp = Ks + rowb + (cb ^ swz);
            kf[2 * i] = *reinterpret_cast<const bf16x8*>(kp);
            kf[2 * i + 1] = *reinterpret_cast<const bf16x8*>(kp + 64 * D); }
        SBAR();
#pragma unroll
        for (int i = 0; i < NBT; ++i) {
            p0 = __builtin_amdgcn_mfma_f32_32x32x16_bf16(kf[2 * i], qr[g4 * NBT + i], p0, 0, 0, 0);
            p1 = __builtin_amdgcn_mfma_f32_32x32x16_bf16(kf[2 * i + 1], qr[g4 * NBT + i], p1, 0, 0, 0); }
        SBAR();
    }
}
template <int D> DI void softmax_tile(f32x16& p0, f32x16& p1, float& m_reg, float& l_reg, float& alpha, bf16x8& pa0, bf16x8& pa1, bf16x8& pa2, bf16x8& pa3, bool rowok) {
    constexpr float SCALE = (D == 64) ? 0.125f : 0.088388347648318440f;
    constexpr float C = SCALE * 1.4426950408889634f, THRR = 8.f / SCALE;
    float pmax = p0[0];
#pragma unroll
    for (int r = 1; r < 16; ++r) pmax = fmaxf(pmax, p0[r]);
#pragma unroll
    for (int r = 0; r < 16; ++r) pmax = fmaxf(pmax, p1[r]);
    { auto rr = __builtin_amdgcn_permlane32_swap(__float_as_uint(pmax), __float_as_uint(pmax), false, false);
      pmax = fmaxf(__uint_as_float(rr[0]), __uint_as_float(rr[1])); }
    if (!rowok) pmax = NEGS;
    float mn;
    if (__builtin_expect(__all(pmax - m_reg <= THRR), 1)) { mn = m_reg; alpha = 1.f; }
    else { mn = fmaxf(m_reg, pmax); alpha = fast_exp2((m_reg - mn) * C); m_reg = mn; }
    const float mnC = rowok ? -mn * C : -__builtin_inff();
#pragma unroll
    for (int r = 0; r < 16; ++r) { p0[r] = fast_exp2(fmaf(p0[r], C, mnC)); p1[r] = fast_exp2(fmaf(p1[r], C, mnC)); }
    float ps = 0.f;
#pragma unroll
    for (int r = 0; r < 16; ++r) ps += p0[r];
#pragma unroll
    for (int r = 0; r < 16; ++r) ps += p1[r];
    { auto rr = __builtin_amdgcn_permlane32_swap(__float_as_uint(ps), __float_as_uint(ps), false, false);
      ps = __uint_as_float(rr[0]) + __uint_as_float(rr[1]); }
    l_reg = l_reg * alpha + ps;
#define PK4(P, BASE, OUT) do { unsigned a0 = cvtpk(P[BASE + 0], P[BASE + 1]), a1 = cvtpk(P[BASE + 2], P[BASE + 3]);   \
    unsigned b0 = cvtpk(P[BASE + 4], P[BASE + 5]), b1 = cvtpk(P[BASE + 6], P[BASE + 7]);                              \
    auto r0 = __builtin_amdgcn_permlane32_swap(a0, b0, false, false); auto r1 = __builtin_amdgcn_permlane32_swap(a1, b1, false, false); \
    u32x4 w = {r0[0], r1[0], r0[1], r1[1]}; OUT = *reinterpret_cast<bf16x8*>(&w); } while (0)
    PK4(p0, 0, pa0); PK4(p0, 8, pa1); PK4(p1, 0, pa2); PK4(p1, 8, pa3);
#undef PK4
}
template <int D, int D0> DI void pv_one(f32x16& od, int vb, bf16x8 pa0, bf16x8 pa1, bf16x8 pa2, bf16x8 pa3) {
    const s16x4 l0 = tr_read<v_rd_off<D>(D0, 0, 0)>(vb), h0 = tr_read<v_rd_off<D>(D0, 0, 1)>(vb), l1 = tr_read<v_rd_off<D>(D0, 1, 0)>(vb), h1 = tr_read<v_rd_off<D>(D0, 1, 1)>(vb);
    const s16x4 l2 = tr_read<v_rd_off<D>(D0, 2, 0)>(vb), h2 = tr_read<v_rd_off<D>(D0, 2, 1)>(vb), l3 = tr_read<v_rd_off<D>(D0, 3, 0)>(vb), h3 = tr_read<v_rd_off<D>(D0, 3, 1)>(vb);
    asm volatile("s_waitcnt lgkmcnt(0)" ::: "memory"); SBAR();
#define PK(L, H) (bf16x8){L[0], L[1], L[2], L[3], H[0], H[1], H[2], H[3]}
    od = __builtin_amdgcn_mfma_f32_32x32x16_bf16(pa0, PK(l0, h0), od, 0, 0, 0);
    od = __builtin_amdgcn_mfma_f32_32x32x16_bf16(pa1, PK(l1, h1), od, 0, 0, 0);
    od = __builtin_amdgcn_mfma_f32_32x32x16_bf16(pa2, PK(l2, h2), od, 0, 0, 0);
    od = __builtin_amdgcn_mfma_f32_32x32x16_bf16(pa3, PK(l3, h3), od, 0, 0, 0);
#undef PK
}
template <int D> DI void pv_all(f32x16* o, int vb, bf16x8 pa0, bf16x8 pa1, bf16x8 pa2, bf16x8 pa3) {
    pv_one<D, 0>(o[0], vb, pa0, pa1, pa2, pa3); pv_one<D, 1>(o[1], vb, pa0, pa1, pa2, pa3);
    if constexpr (D == 128) { pv_one<D, 2>(o[2], vb, pa0, pa1, pa2, pa3); pv_one<D, 3>(o[3], vb, pa0, pa1, pa2, pa3); }
}
template <int D> struct StgH { bf16x8 x[D / 64]; };
template <int D> DI void stg_ld(StgH<D>& s, const bf16_t* g, int pitch, int tid) {
    if constexpr (D == 128) { const int sr = tid >> 4, sc = (tid & 15) * 8;
        s.x[0] = *(const GAS bf16x8*)(g + (size_t)sr * pitch + sc); s.x[1] = *(const GAS bf16x8*)(g + (size_t)(sr + 32) * pitch + sc);
    } else { const int sr = tid >> 3, sc = (tid & 7) * 8; s.x[0] = *(const GAS bf16x8*)(g + (size_t)sr * pitch + sc); }
}
template <int D> DI void stg_wrK(const StgH<D>& s, char* Kl, int tid) {
    if constexpr (D == 128) { const int sr = tid >> 4, sc = (tid & 15) * 8; *(bf16x8*)(Kl + koff<D>(sr, sc * 2)) = s.x[0]; *(bf16x8*)(Kl + koff<D>(sr + 32, sc * 2)) = s.x[1]; }
    else { const int sr = tid >> 3, sc = (tid & 7) * 8; *(bf16x8*)(Kl + koff<D>(sr, sc * 2)) = s.x[0]; }
}
template <int D> DI void stg_wrV(const StgH<D>& s, char* Vl, int tid) {
    if constexpr (D == 128) { const int sr = tid >> 4, sc = (tid & 15) * 8; *(bf16x8*)(Vl + v_st<D>(sr, sc)) = s.x[0]; *(bf16x8*)(Vl + v_st<D>(sr + 32, sc)) = s.x[1]; }
    else { const int sr = tid >> 3, sc = (tid & 7) * 8; *(bf16x8*)(Vl + v_st<D>(sr, sc)) = s.x[0]; }
}
#define LBAR() asm volatile("s_waitcnt lgkmcnt(0)\n\ts_barrier" ::: "memory")
template <int D, class MaskF>
DI void tile_finish(Core<D>& c, f32x16& p0, f32x16& p1, int j, const MaskF& mk, float* ws, int vb, int r32, int hi) {
    if (mk.partial(j)) { const int kb = 64 * j;
#pragma unroll
        for (int r = 0; r < 16; ++r) { const int k0 = kb + crow(r, hi); if (!mk.ok(j, k0)) p0[r] = NEGS; if (!mk.ok(j, k0 + 32)) p1[r] = NEGS; } }
    float alpha; bf16x8 pa0, pa1, pa2, pa3;
    softmax_tile<D>(p0, p1, c.m_reg, c.l_reg, alpha, pa0, pa1, pa2, pa3, mk.rowok(j));
    if (__any(alpha < 1.f)) { if (hi == 0) ws[32 + r32] = alpha; LDS_WAIT();
#pragma unroll
        for (int r = 0; r < 16; ++r) { const float a = ws[32 + crow(r, hi)];
#pragma unroll
            for (int d = 0; d < D / 32; ++d) c.o[d][r] *= a; } }
    SBAR();
    pv_all<D>(c.o, vb, pa0, pa1, pa2, pa3);
}
template <int D, bool PIPE, class Seq, class MaskF, class KX>
DI void run_tiles(Core<D>& c, char* kv, float* ws, const bf16_t* Kg0, const bf16_t* Vg0, int pitch, const Seq& seq, const MaskF& mk, const KX& kx, int tid_, int lane_) {
    constexpr int KB = 64 * D * 2;
    int tid = tid_, lane = lane_; asm volatile("" : "+v"(tid), "+v"(lane));
    const int r32 = lane & 31, hi = lane >> 5;
    int t0; if (!seq.first(t0)) return;
    const int vb0 = (int)(uintptr_t)(kv + 2 * KB) + v_rd_base(lane);
    StgH<D> sk, sv;
    if constexpr (!PIPE) {
        stg_ld<D>(sk, Kg0 + (size_t)64 * t0 * pitch, pitch, tid); stg_ld<D>(sv, Vg0 + (size_t)64 * t0 * pitch, pitch, tid);
        LBAR();
        kx.apply(sk, t0, tid); stg_wrK<D>(sk, kv, tid); stg_wrV<D>(sv, kv + 2 * KB, tid);
        LBAR();
        int buf = 0;
        for (;;) {
            int t1 = 0; const bool e1 = seq.next(t0, t1);
            if (e1) { stg_ld<D>(sk, Kg0 + (size_t)64 * t1 * pitch, pitch, tid); stg_ld<D>(sv, Vg0 + (size_t)64 * t1 * pitch, pitch, tid); }
            f32x16 p0, p1; qkt<D>(p0, p1, kv + buf * KB, c.qr, r32, hi);
            tile_finish<D>(c, p0, p1, t0, mk, ws, vb0 + buf * KB, r32, hi);
            if (e1) { kx.apply(sk, t1, tid); stg_wrK<D>(sk, kv + (buf ^ 1) * KB, tid); stg_wrV<D>(sv, kv + 2 * KB + (buf ^ 1) * KB, tid); }
            LBAR();
            if (!e1) break;
            t0 = t1; buf ^= 1;
        }
    } else {
    int t1 = 0, t2 = 0, t3 = 0;
    bool e1 = seq.next(t0, t1), e2 = e1 && seq.next(t1, t2), e3 = e2 && seq.next(t2, t3);
    stg_ld<D>(sk, Kg0 + (size_t)64 * t0 * pitch, pitch, tid); stg_ld<D>(sv, Vg0 + (size_t)64 * t0 * pitch, pitch, tid);
    LBAR();
    kx.apply(sk, t0, tid); stg_wrK<D>(sk, kv, tid); stg_wrV<D>(sv, kv + 2 * KB, tid);
    if (e1) { stg_ld<D>(sk, Kg0 + (size_t)64 * t1 * pitch, pitch, tid); kx.apply(sk, t1, tid); stg_wrK<D>(sk, kv + KB, tid); }
    LBAR();
    f32x16 pA0, pA1, pB0, pB1;
    qkt<D>(pA0, pA1, kv, c.qr, r32, hi);
    if (e2) stg_ld<D>(sk, Kg0 + (size_t)64 * t2 * pitch, pitch, tid);
    if (e1) stg_ld<D>(sv, Vg0 + (size_t)64 * t1 * pitch, pitch, tid);
    LBAR();
#define ATT_STEP(P0, P1, Q0, Q1, PAR) do { \
        if (e2) { kx.apply(sk, t2, tid); stg_wrK<D>(sk, kv + (PAR) * KB, tid); } \
        if (e1) stg_wrV<D>(sv, kv + 2 * KB + ((PAR) ^ 1) * KB, tid); \
        if (e3) stg_ld<D>(sk, Kg0 + (size_t)64 * t3 * pitch, pitch, tid); \
        if (e2) stg_ld<D>(sv, Vg0 + (size_t)64 * t2 * pitch, pitch, tid); \
        if (e1) qkt<D>(Q0, Q1, kv + ((PAR) ^ 1) * KB, c.qr, r32, hi); \
        tile_finish<D>(c, P0, P1, t0, mk, ws, vb0 + (PAR) * KB, r32, hi); \
        LBAR(); \
    } while (0)
    for (;;) {
        ATT_STEP(pA0, pA1, pB0, pB1, 0);
        if (!e1) break;
        t0 = t1; t1 = t2; t2 = t3; e1 = e2; e2 = e3; e3 = e2 && seq.next(t2, t3);
        ATT_STEP(pB0, pB1, pA0, pA1, 1);
        if (!e1) break;
        t0 = t1; t1 = t2; t2 = t3; e1 = e2; e2 = e3; e3 = e2 && seq.next(t2, t3);
    }
#undef ATT_STEP
    }
}
#undef SBAR
}

struct Args { const float* in[24]; float* out; unsigned char* ws; };
template <int OFF> DI unsigned long long karg_u64() {
    unsigned long long v; auto kp = __builtin_amdgcn_kernarg_segment_ptr();
    asm volatile("s_load_dwordx2 %0, %1, %2\n\ts_waitcnt lgkmcnt(0)" : "=s"(v) : "s"(kp), "n"(OFF));
    return v;
}
template <int I> DI const float* arg_in() { return (const float*)karg_u64<8 * I>(); }
DI float* arg_out() { return (float*)karg_u64<192>(); }
DI unsigned char* arg_ws() { return (unsigned char*)karg_u64<200>(); }

DI float wave_sum(float v) {
#pragma unroll
    for (int o = 1; o < 64; o <<= 1) v += __shfl_xor(v, o);
    return v;
}
struct TJob { const float* src; const float* gain; bf16_t* dst; int K, pitch, nsrc, ndst, mode, coff; };
DI void get_job(int j, TJob& J) {
    unsigned char* ws = arg_ws(); J.gain = nullptr; J.mode = 0; J.coff = 0;
    if (j < 16) { const int L = j >> 2, k = j & 3, w = k >> 1;
        if ((k & 1) == 0) { J.src = (w ? arg_in<7>() : arg_in<3>()) + (size_t)L * DM * NFF; J.gain = (w ? arg_in<6>() : arg_in<2>()) + (size_t)L * DM; J.dst = (bf16_t*)(ws + WS_WFI + (size_t)(L * 2 + w) * SZ_WFI);
            J.K = DM; J.pitch = NFF; J.nsrc = NFF; J.ndst = NFF; J.mode = 1; }
        else { J.src = (w ? arg_in<8>() : arg_in<4>()) + (size_t)L * DFF * DM; J.dst = (bf16_t*)(ws + WS_WFO + (size_t)(L * 2 + w) * SZ_WFO); J.K = DFF; J.pitch = DM; J.nsrc = DM; J.ndst = DM; }
    } else if (j < 24) { const int jj = j - 16, L2 = jj >> 2, k = jj & 3;
        if (k == 0) { J.src = arg_in<9>() + (size_t)L2 * DM * SW_N; J.gain = arg_in<5>() + (size_t)(2 * L2) * DM; J.dst = (bf16_t*)(ws + WS_WSI + (size_t)L2 * SZ_WSI); J.K = DM; J.pitch = SW_N; J.nsrc = SW_N; J.ndst = SW_N; }
        else if (k == 1) { J.src = arg_in<13>() + (size_t)L2 * DM * DM; J.dst = (bf16_t*)(ws + WS_WSO + (size_t)L2 * SZ_WO); J.K = DM; J.pitch = DM; J.nsrc = DM; J.ndst = DM; }
        else if (k == 2) { J.src = arg_in<14>() + (size_t)L2 * DM * NS_NREAL; J.gain = arg_in<5>() + (size_t)(2 * L2 + 1) * DM; J.dst = (bf16_t*)(ws + WS_WNI + (size_t)L2 * SZ_WNI); J.K = DM; J.pitch = NS_NREAL; J.nsrc = NS_N; J.ndst = NS_N; }
        else { J.src = arg_in<23>() + (size_t)L2 * DM * DM; J.dst = (bf16_t*)(ws + WS_WNO + (size_t)L2 * SZ_WO); J.K = DM; J.pitch = DM; J.nsrc = DM; J.ndst = DM; }
    } else if (j >= 32) { const int L2 = j - 32;
        J.src = arg_in<14>() + (size_t)L2 * DM * NS_NREAL; J.gain = arg_in<5>() + (size_t)(2 * L2 + 1) * DM; J.dst = (bf16_t*)(ws + WS_WG + (size_t)L2 * SZ_WG); J.K = DM; J.pitch = NS_NREAL; J.nsrc = 48; J.ndst = 64; J.coff = NS_N;
    } else { const int jj = j - 24, L2 = jj >> 2, k = jj & 3;
        if (k < 2) { J.src = (k == 0 ? arg_in<18>() : arg_in<21>()) + (size_t)L2 * 4096 * 256; J.dst = (bf16_t*)(ws + WS_W1 + (size_t)(L2 * 2 + k) * SZ_W1); J.K = 4096; J.pitch = 256; J.nsrc = 256; J.ndst = 256; J.mode = 2; }
        else { J.src = (k == 2 ? arg_in<19>() : arg_in<22>()) + (size_t)L2 * 256 * 128; J.dst = (bf16_t*)(ws + WS_W2 + (size_t)(L2 * 2 + (k - 2)) * SZ_W2); J.K = 256; J.pitch = 128; J.nsrc = 128; J.ndst = 128; }
    }
}
DI void transpose_item(const TJob& J, LAS float* scr, int item, int lane) {
    const int nblk = J.ndst / 64, kb = item / nblk, nb = item % nblk, k0 = 64 * kb, n0 = 64 * nb;
    int sc0 = n0; if (J.mode == 1) sc0 = ((n0 & 255) >> 7) * DFF + (n0 >> 8) * 128 + (n0 & 127);
    const int ln = lane & 15, kr = lane >> 4;
    const int col = J.coff + sc0 + 4 * ln; const bool okc = (n0 + 4 * ln) < J.nsrc;
    f32x4 v[16];
#pragma unroll
    for (int i = 0; i < 16; ++i) v[i] = okc ? __builtin_nontemporal_load((const GAS f32x4*)(J.src + (size_t)(k0 + 4 * i + kr) * J.pitch + col)) : (f32x4){0.f, 0.f, 0.f, 0.f};
#pragma unroll
    for (int i = 0; i < 16; ++i) { LAS float* d = scr + (4 * i + kr) * 65 + 4 * ln; d[0] = v[i][0]; d[1] = v[i][1]; d[2] = v[i][2]; d[3] = v[i][3]; }
    const int c = lane & 7;
    f32x4 ga = {1.f, 1.f, 1.f, 1.f}, gb = {1.f, 1.f, 1.f, 1.f};
    if (J.gain) { ga = *(const GAS f32x4*)(J.gain + k0 + 8 * c); gb = *(const GAS f32x4*)(J.gain + k0 + 8 * c + 4); }
    LDS_WAIT(); asm volatile("" ::: "memory");
#pragma unroll
    for (int jx = 0; jx < 8; ++jx) { const int n = (lane >> 3) + 8 * jx; const LAS float* s = scr + (8 * c) * 65 + n;
        u32x4 o; o.x = cvtpk(s[0 * 65] * ga[0], s[1 * 65] * ga[1]); o.y = cvtpk(s[2 * 65] * ga[2], s[3 * 65] * ga[3]); o.z = cvtpk(s[4 * 65] * gb[0], s[5 * 65] * gb[1]); o.w = cvtpk(s[6 * 65] * gb[2], s[7 * 65] * gb[3]);
        const int nn = n0 + n, k8 = (k0 >> 3) + c;
        const size_t di = J.mode == 2 ? ((size_t)((nn >> 5) * (J.K >> 4) + (k8 >> 1)) * 64 + (nn & 31) + 32 * (k8 & 1)) * 8
                                       : (size_t)nn * J.K + k0 + 8 * c;
        *(GAS u32x4*)(J.dst + di) = o; }
    LDS_WAIT(); asm volatile("" ::: "memory");
}
constexpr int NJOBS_PRO = 30;
__device__ const unsigned char JOB_ORDER[NJOBS_PRO] = {12,13,14,15,22,23,28,29,30,31,33,8,9,10,20,4,5,6,7,18,19,24,25,26,27,32,16,2,1,0};
DI void prologue(LAS unsigned char* lds, int vcu, int G, int wave, int lane) {
    unsigned char* const wsb = arg_ws();
    LAS float* scr = (LAS float*)(lds + wave * 16640);
    const int gw = vcu * NWAVES + wave, NGW = G * NWAVES;
    {
        const int* pos = (const int*)arg_in<1>();
        float* t64 = (float*)(wsb + WS_ROPE64); float* t128 = (float*)(wsb + WS_ROPE128);
        const int i = lane < 8 ? lane : lane - 8;
        const double ex = lane < 8 ? (double)i / 8.0 : (double)i / 16.0;
        const float inv = (float)(1.0 / exp2(ex * 18.931568569324174));
        for (int m = gw; m < M; m += NGW) {
            if (lane < 24) {
                const float ang = (float)((const GAS int*)pos)[m] * inv;
                double rev = (double)ang * 0.15915494309189535; rev -= floor(rev);
                const float fr = (float)rev;
                const float sn = __builtin_amdgcn_sinf(fr), cs = __builtin_amdgcn_cosf(fr);
                if (lane < 8) { ((GAS float*)t64)[(size_t)m * 16 + i] = cs; ((GAS float*)t64)[(size_t)m * 16 + 8 + i] = sn; }
                else { ((GAS float*)t128)[(size_t)m * 32 + i] = cs; ((GAS float*)t128)[(size_t)m * 32 + 16 + i] = sn; }
            }
        }
    }
    {
        const float* x = arg_in<0>(); bf16_t* hb = (bf16_t*)(wsb + WS_HB); bf16_t* lb = (bf16_t*)(wsb + WS_LB); float* rowss = (float*)(wsb + WS_ROWSS);
        for (int m = gw; m < M; m += NGW) {
            const GAS f32x4* xr = (const GAS f32x4*)(x + (size_t)m * DM) + lane; float s = 0.f;
            GAS u32x2* l8 = (GAS u32x2*)(lb + (size_t)m * DM) + lane;
#pragma unroll
            for (int jx = 0; jx < 8; ++jx) { const f32x4 v = xr[64 * jx]; s += (v[0] * v[0] + v[1] * v[1]) + (v[2] * v[2] + v[3] * v[3]);
                u32x2 w; w.x = cvtpk(v[0], v[1]); w.y = cvtpk(v[2], v[3]);
                { const int c = (jx * 64 + lane) * 4; *(GAS u32x2*)(hb + (size_t)(c >> 8) * ((size_t)M * 256) + (size_t)m * 256 + (c & 255)) = w; }
                if (RES_LO) { u32x2 wl; wl.x = cvtpk(v[0] - bflo(w.x), v[1] - bfhi(w.x)); wl.y = cvtpk(v[2] - bflo(w.y), v[3] - bfhi(w.y)); l8[64 * jx] = wl; } }
            s = wave_sum(s);
            if (lane < 32) ((GAS float*)rowss)[(size_t)lane * M + m] = lane == 0 ? s : 0.f;
        }
    }
    {
        for (int tk = gw; tk < 128; tk += NGW) { const int L2 = tk >> 6, kvi = (tk >> 5) & 1, l = tk & 31;
            const float* pe = (kvi ? arg_in<20>() : arg_in<17>()) + (size_t)L2 * 32 * 128 + l * 128;
            const float* w1 = (kvi ? arg_in<21>() : arg_in<18>()) + (size_t)L2 * 4096 * 256 + (size_t)l * 128 * 256;
            f32x4 acc = {0.f, 0.f, 0.f, 0.f};
            for (int d = 0; d < 128; ++d) { const float p = ((const GAS float*)pe)[d]; const f32x4 w = ((const GAS f32x4*)(w1 + (size_t)d * 256))[lane]; acc += w * p; }
            ((GAS f32x4*)(wsb + WS_BIASP + (size_t)(L2 * 2 + kvi) * SZ_BIASP + (size_t)l * 256 * 4))[lane] = acc;
        }
    }
    int off = gw;
    for (int jo = 0; jo < NJOBS_PRO; ++jo) {
        const int j = (int)JOB_ORDER[jo];
        TJob J; get_job(j, J);
        const int nitems = (J.K / 64) * (J.ndst / 64);
        int it = off;
        for (; it < nitems; it += NGW) transpose_item(J, scr, it, lane);
        off = it - nitems;
    }
}

DI void convert_deferred(LAS unsigned char* lds, int L2, int idx, int NIDLE, int wave, int lane) {
    LAS float* scr = (LAS float*)(lds + wave * 16640);
    const int gw = idx * NWAVES + wave, NGW = NIDLE * NWAVES;
    int off = gw;
#pragma unroll 1
    for (int q = 0; q < 2; ++q) {
        const int j = q == 0 ? 17 + 4 * L2 : 3 + 8 * L2;
        TJob J; get_job(j, J);
        const int nitems = (J.K / 64) * (J.ndst / 64);
        int it = off;
        for (; it < nitems; it += NGW) transpose_item(J, scr, it, lane);
        off = it - nitems;
    }
}

template <int CTRL> DI float dppf(float v) { return __builtin_bit_cast(float, __builtin_amdgcn_update_dpp(0, __builtin_bit_cast(int, v), CTRL, 0xF, 0xF, false)); }
template <int LPR> DI float row_sum(float ss) {
    ss += dppf<0xB1>(ss); ss += dppf<0x4E>(ss); ss += dppf<0x141>(ss);
    if constexpr (LPR == 16) ss += dppf<0x140>(ss);
    return ss;
}
template <int HD> DI void norm_rope8(float (&x)[8], const float* gain, const float* tab  , int sub) {
    constexpr int LPR = HD / 8, HALFR = HD / 8;
    float ss = 0.f;
#pragma unroll
    for (int e = 0; e < 8; ++e) ss += x[e] * x[e];
    if constexpr (HD == 64) ss = row_sum<LPR>(ss); else {
#pragma unroll
    for (int o = 1; o < LPR; o <<= 1) ss += __shfl_xor(ss, o); }
    const float rs = rsqrtf(ss * (1.0f / HD) + EPS);
#pragma unroll
    for (int e = 0; e < 8; ++e) x[e] = x[e] * rs * ((const GAS float*)gain)[sub * 8 + e];
    constexpr int XL = HALFR / 8;
    float y[8];
#pragma unroll
    for (int e = 0; e < 8; ++e) { if constexpr (HD == 64) y[e] = dppf<XL == 1 ? 0xB1 : 0x4E>(x[e]); else y[e] = __shfl_xor(x[e], XL); }
    if (sub < 2 * XL) {
        const bool first = sub < XL; const int i0 = (sub & (XL - 1)) * 8;
#pragma unroll
        for (int e = 0; e < 8; ++e) { const float cs = ((const GAS float*)tab)[i0 + e], sn = ((const GAS float*)tab)[HALFR + i0 + e];
            x[e] = first ? (x[e] * cs - y[e] * sn) : (x[e] * cs + y[e] * sn); }
    }
}
template <int D> DI void qnorm_rope(att::Core<D>& c, const float* gain, const float* tab, int hi) {
    constexpr int ND = D / 16, HALFR = D / 8;
    float x[ND][8]; float ss = 0.f;
#pragma unroll
    for (int d0 = 0; d0 < ND; ++d0) { const u32x4 w = __builtin_bit_cast(u32x4, c.qr[d0]);
        x[d0][0] = bflo(w.x); x[d0][1] = bfhi(w.x); x[d0][2] = bflo(w.y); x[d0][3] = bfhi(w.y); x[d0][4] = bflo(w.z); x[d0][5] = bfhi(w.z); x[d0][6] = bflo(w.w); x[d0][7] = bfhi(w.w);
#pragma unroll
        for (int e = 0; e < 8; ++e) ss += x[d0][e] * x[d0][e]; }
    ss = sum_xor32(ss);
    const float rs = __builtin_amdgcn_rsqf(ss * (1.0f / D) + EPS);
#pragma unroll
    for (int d0 = 0; d0 < ND; ++d0) { const f32x4 ga = *(const GAS f32x4*)(gain + d0 * 16 + hi * 8), gb = *(const GAS f32x4*)(gain + d0 * 16 + hi * 8 + 4);
#pragma unroll
        for (int e = 0; e < 8; ++e) x[d0][e] = x[d0][e] * rs * (e < 4 ? ga[e] : gb[e - 4]); }
    if constexpr (D == 64) {
        const f32x4 ca = *(const GAS f32x4*)(tab), cb = *(const GAS f32x4*)(tab + 4), sa = *(const GAS f32x4*)(tab + HALFR), sb = *(const GAS f32x4*)(tab + HALFR + 4);
#pragma unroll
        for (int e = 0; e < 8; ++e) { const float cs = e < 4 ? ca[e] : cb[e - 4], sn = e < 4 ? sa[e] : sb[e - 4];
            auto rr = __builtin_amdgcn_permlane32_swap(__float_as_uint(x[0][e]), __float_as_uint(x[0][e]), false, false);
            const float y = __uint_as_float(hi ? rr[0] : rr[1]);
            x[0][e] = hi ? (x[0][e] * cs + y * sn) : (x[0][e] * cs - y * sn); }
    } else {
        const f32x4 ca = *(const GAS f32x4*)(tab + hi * 8), cb = *(const GAS f32x4*)(tab + hi * 8 + 4), sa = *(const GAS f32x4*)(tab + HALFR + hi * 8), sb = *(const GAS f32x4*)(tab + HALFR + hi * 8 + 4);
#pragma unroll
        for (int e = 0; e < 8; ++e) { const float cs = e < 4 ? ca[e] : cb[e - 4], sn = e < 4 ? sa[e] : sb[e - 4];
            const float x1 = x[0][e], x2 = x[1][e]; x[0][e] = x1 * cs - x2 * sn; x[1][e] = x2 * cs + x1 * sn; }
    }
#pragma unroll
    for (int d0 = 0; d0 < ND; ++d0) { u32x4 w; w.x = cvtpk(x[d0][0], x[d0][1]); w.y = cvtpk(x[d0][2], x[d0][3]); w.z = cvtpk(x[d0][4], x[d0][5]); w.w = cvtpk(x[d0][6], x[d0][7]); c.qr[d0] = __builtin_bit_cast(bf16x8, w); }
}
struct KxNone { DI void apply(att::StgH<64>&, int, int) const {} DI void apply(att::StgH<128>&, int, int) const {} };
struct KxNorm64 { const float* gain; const float* tab;
    DI void apply(att::StgH<64>& s, int tile, int tid) const {
        const int sr = tid >> 3, sub = tid & 7; const u32x4 w = __builtin_bit_cast(u32x4, s.x[0]); float x[8];
        x[0] = bflo(w.x); x[1] = bfhi(w.x); x[2] = bflo(w.y); x[3] = bfhi(w.y); x[4] = bflo(w.z); x[5] = bfhi(w.z); x[6] = bflo(w.w); x[7] = bfhi(w.w);
        norm_rope8<64>(x, gain, tab + (size_t)(64 * tile + sr) * 16, sub);
        u32x4 o; o.x = cvtpk(x[0], x[1]); o.y = cvtpk(x[2], x[3]); o.z = cvtpk(x[4], x[5]); o.w = cvtpk(x[6], x[7]); s.x[0] = __builtin_bit_cast(bf16x8, o); }
    DI void apply(att::StgH<128>&, int, int) const {} };
DI void ld8(const bf16_t* p, float (&x)[8]) { const u32x4 w = *(const GAS u32x4*)p; x[0] = bflo(w.x); x[1] = bfhi(w.x); x[2] = bflo(w.y); x[3] = bfhi(w.y); x[4] = bflo(w.z); x[5] = bfhi(w.z); x[6] = bflo(w.w); x[7] = bfhi(w.w); }
DI void st8(bf16_t* p, const float (&x)[8]) { u32x4 w; w.x = cvtpk(x[0], x[1]); w.y = cvtpk(x[2], x[3]); w.z = cvtpk(x[4], x[5]); w.w = cvtpk(x[6], x[7]); *(GAS u32x4*)p = w; }

DI void nsa_normrope(int L2, int gw, int NGW, int lane) {
    unsigned char* const wsb = arg_ws();
    bf16_t* qkv = (bf16_t*)(wsb + WS_ACT); const float* tab = (const float*)(wsb + WS_ROPE128);
    const float* kg = arg_in<16>() + L2 * 128;
    const int grp = lane >> 4, sub = lane & 15;
    float gn[8];
#pragma unroll
    for (int e = 0; e < 8; ++e) gn[e] = ((const GAS float*)kg)[sub * 8 + e];
    const bool roper = sub < 4, first = sub < 2; const int i0 = (sub & 1) * 8;
    const long nrows = (long)M * 8, stride = (long)NGW * 4;
    for (long hr0 = (long)gw * 4 + grp; hr0 < nrows; hr0 += stride * 4) {
        u32x4 w[4]; f32x4 ca[4], cb[4], sa[4], sb[4]; bf16_t* p[4]; bool ok[4];
#pragma unroll
        for (int u = 0; u < 4; ++u) { const long hr = hr0 + u * stride; ok[u] = hr < nrows; const long hq = ok[u] ? hr : hr0;
            const int m = (int)(hq >> 3), j = (int)(hq & 7); const int col = j < 4 ? NS_KS + j * 128 : NS_KW + (j - 4) * 128;
            p[u] = qkv + (size_t)m * NS_N + col + sub * 8; w[u] = *(const GAS u32x4*)p[u];
            const float* t = tab + (size_t)m * 32 + i0;
            ca[u] = *(const GAS f32x4*)t; cb[u] = *(const GAS f32x4*)(t + 4); sa[u] = *(const GAS f32x4*)(t + 16); sb[u] = *(const GAS f32x4*)(t + 20); }
#pragma unroll
        for (int u = 0; u < 4; ++u) {
            float x[8]; x[0] = bflo(w[u].x); x[1] = bfhi(w[u].x); x[2] = bflo(w[u].y); x[3] = bfhi(w[u].y); x[4] = bflo(w[u].z); x[5] = bfhi(w[u].z); x[6] = bflo(w[u].w); x[7] = bfhi(w[u].w);
            float ss = 0.f;
#pragma unroll
            for (int e = 0; e < 8; ++e) ss += x[e] * x[e];
            ss = row_sum<16>(ss);
            const float rs = rsqrtf(ss * (1.0f / 128) + EPS);
#pragma unroll
            for (int e = 0; e < 8; ++e) x[e] = x[e] * rs * gn[e];
            float y[8];
#pragma unroll
            for (int e = 0; e < 8; ++e) y[e] = dppf<0x4E>(x[e]);
            if (roper) {
#pragma unroll
                for (int e = 0; e < 8; ++e) { const float cs = e < 4 ? ca[u][e] : cb[u][e - 4], sn = e < 4 ? sa[u][e] : sb[u][e - 4];
                    x[e] = first ? (x[e] * cs - y[e] * sn) : (x[e] * cs + y[e] * sn); }
            }
            if (ok[u]) st8(p[u], x);
        }
    }
}

struct SeqRange { int lo, hi; DI bool first(int& j) const { j = lo; return lo <= hi; } DI bool next(int j, int& jn) const { jn = j + 1; return jn <= hi; } };
struct MaskWin { int t, w, tmin, tmax;
    DI bool ok(int, int key) const { return key <= t && key > t - w; }
    DI bool partial(int j) const { return !(64 * j + 63 <= tmin && 64 * j > tmax - w); }
    DI bool rowok(int) const { return true; } };
DI void swa_attention(int L2, char* lds, int vcu, int G, int tid, int wave, int lane) {
#define SWA_QKV ((const bf16_t*)(arg_ws() + WS_ACT))
#define SWA_RTAB ((const float*)(arg_ws() + WS_ROPE64))
    const int r32 = lane & 31, hi = lane >> 5;
    float* ws = (float*)(lds + 32768) + wave * 64;
    bf16_t* stg = (bf16_t*)(lds + 32768 + 2048) + wave * 2048;
    constexpr int NU = NB * 4 * (T / 32);
    const int per = (NU + G - 1) / G;
    for (int ui = 0; ui < per; ++ui) {
        const int u = vcu * per + ui; if (u >= NU) break;
        const int bg = u / (T / 32), qt = u % (T / 32), b = bg >> 2, g = bg & 3;
        const int t0 = qt * 32, t = t0 + r32, h = 8 * g + wave;
        att::Core<64> c;
        att::load_q<64>(c, SWA_QKV + (size_t)(b * T + t) * SW_N + h * 64, hi);
        qnorm_rope<64>(c, arg_in<10>() + L2 * 64, SWA_RTAB + (size_t)(b * T + t) * 16, hi);
        const float sink = ((const GAS float*)(arg_in<12>() + L2 * 32))[h];
        att::core_reset<64>(c, sink * 8.0f, 1.0f);
        SeqRange seq; seq.lo = (t0 - 127) < 0 ? 0 : ((t0 - 127) >> 6); seq.hi = (t0 + 31) >> 6;
        MaskWin mk; mk.t = t; mk.w = 128; mk.tmin = t0; mk.tmax = t0 + 31;
        KxNorm64 kx; kx.gain = arg_in<11>() + L2 * 64; kx.tab = SWA_RTAB + (size_t)b * T * 16;
        att::run_tiles<64, true>(c, lds, ws, SWA_QKV + (size_t)b * T * SW_N + 2048 + g * 64, SWA_QKV + (size_t)b * T * SW_N + 2304 + g * 64, SW_N, seq, mk, kx, tid, lane);
        if (hi == 0) ws[r32] = fast_rcp(c.l_reg);
        LDS_WAIT();
#pragma unroll
        for (int r = 0; r < 16; ++r) { const int orow = att::crow(r, hi); const float f = ws[orow];
#pragma unroll
            for (int d0 = 0; d0 < 2; ++d0) stg[orow * 64 + d0 * 32 + r32] = f2bf1(c.o[d0][r] * f); }
        LDS_WAIT();
#pragma unroll
        for (int i = 0; i < 4; ++i) { const int row = i * 8 + (lane >> 3), ch = lane & 7; const u32x4 v = *(const u32x4*)(stg + row * 64 + ch * 8);
            *(GAS u32x4*)((bf16_t*)(arg_ws() + WS_OB) + (size_t)(b * T + t0 + row) * DM + h * 64 + ch * 8) = v; }
        LDS_WAIT();
    }
}

DI void nsa_compress(int L2, char* lds, int vcu, int G, int tid, int wave, int lane) {
    unsigned char* const wsb = arg_ws(); const float* const kgain = arg_in<16>() + L2 * 128;
    const bf16_t* qkv = (const bf16_t*)(wsb + WS_ACT);
    const int r32 = lane & 31, hi = lane >> 5;
    char* abuf = lds; bf16_t* hid = (bf16_t*)(lds + 65536); float* outf = (float*)(lds + 65536 + 17408);
    const int sn = tid >> 4, sc16 = tid & 15;
    for (int it = vcu; it < 256; it += G) {
        const int kvi = it >> 7, bg = (it >> 3) & 15, nt = it & 7, b = bg >> 2, g = bg & 3, n0 = nt * 32;
        const bf16_t* w1t = (const bf16_t*)(wsb + WS_W1 + (size_t)(L2 * 2 + kvi) * SZ_W1);
        const bf16_t* w2t = (const bf16_t*)(wsb + WS_W2 + (size_t)(L2 * 2 + kvi) * SZ_W2);
        const float* biasp = (const float*)(wsb + WS_BIASP + (size_t)(L2 * 2 + kvi) * SZ_BIASP);
        const int colb = (kvi ? NS_VC : NS_KC) + g * 128;
        f32x16 acc;
#pragma unroll
        for (int r = 0; r < 16; ++r) acc[r] = 0.f;
        const bf16_t* brow = w1t + ((size_t)wave * 256 * 64 + lane) * 8;
        bf16x8 areg[8];
#define CMP_ALOAD(ck) do { _Pragma("unroll") for (int i_ = 0; i_ < 8; ++i_) { int tok_ = 16 * (n0 + sn) + 8 * (ck) + i_; tok_ = tok_ > T - 1 ? T - 1 : tok_; \
            areg[i_] = *(const GAS bf16x8*)(qkv + (size_t)(b * T + tok_) * NS_N + colb + sc16 * 8); } } while (0)
#define CMP_BLOAD(dst, l2) do { _Pragma("unroll") for (int q_ = 0; q_ < 16; ++q_) dst[q_] = *(const GAS bf16x8*)(brow + (size_t)(16 * (l2) + q_) * 512); } while (0)
        CMP_ALOAD(0);
        bf16x8 bA[16], bB[16];
        CMP_BLOAD(bA, 0);
        __syncthreads();
        for (int ck = 0; ck < 4; ++ck) {
#pragma unroll
            for (int i = 0; i < 8; ++i) *(bf16x8*)(abuf + i * 8192 + att::koff<128>(sn, sc16 * 16)) = areg[i];
            __syncthreads();
            if (ck < 3) CMP_ALOAD(ck + 1);
#pragma unroll
            for (int p = 0; p < 4; ++p) {
                const int l2 = ck * 4 + p;
                if (p & 1) { if (l2 + 1 < 16) CMP_BLOAD(bA, l2 + 1); } else { CMP_BLOAD(bB, l2 + 1); }
#pragma unroll
                for (int q = 0; q < 16; ++q) {
                    const bf16x8 av = *(const bf16x8*)(abuf + (2 * p + (q >> 3)) * 8192 + att::koff<128>(r32, ((q & 7) * 16 + hi * 8) * 2));
                    acc = __builtin_amdgcn_mfma_f32_32x32x16_bf16(av, (p & 1) ? bB[q] : bA[q], acc, 0, 0, 0);
                }
            }
            __syncthreads();
        }
#undef CMP_ALOAD
#undef CMP_BLOAD
        float bias = 0.f;
        { float bl[32];
#pragma unroll
          for (int l = 0; l < 32; ++l) bl[l] = ((const GAS float*)biasp)[l * 256 + 32 * wave + r32];
#pragma unroll
          for (int l = 0; l < 32; ++l) bias += bl[l]; }
#pragma unroll
        for (int r = 0; r < 16; ++r) hid[att::crow(r, hi) * 264 + 32 * wave + r32] = f2bf1(silu(acc[r] + bias));
        __syncthreads();
        if (wave < 4) {
            f32x16 o2;
#pragma unroll
            for (int r = 0; r < 16; ++r) o2[r] = 0.f;
            const bf16_t* b2 = w2t + (size_t)(32 * wave + r32) * 256 + hi * 8;
#pragma unroll
            for (int k0 = 0; k0 < 16; ++k0) {
                const bf16x8 av = *(const bf16x8*)(hid + r32 * 264 + k0 * 16 + hi * 8);
                const bf16x8 bv = *(const GAS bf16x8*)(b2 + k0 * 16);
                o2 = __builtin_amdgcn_mfma_f32_32x32x16_bf16(av, bv, o2, 0, 0, 0);
            }
#pragma unroll
            for (int r = 0; r < 16; ++r) outf[att::crow(r, hi) * 132 + 32 * wave + r32] = o2[r];
        }
        __syncthreads();
        {
            const int grp = lane >> 4, sub = lane & 15, row = wave * 4 + grp, nn = n0 + row;
            float x[8];
#pragma unroll
            for (int e = 0; e < 8; ++e) x[e] = outf[row * 132 + sub * 8 + e];
            if (kvi == 0) {
                int tok = 16 * nn + 31; tok = tok > T - 1 ? T - 1 : tok;
                norm_rope8<128>(x, kgain, (const float*)(wsb + WS_ROPE128) + (size_t)(b * T + tok) * 32, sub);
            }
            bf16_t* dst = (bf16_t*)(wsb + (kvi ? WS_VC : WS_KC)) + ((size_t)(b * 256 + nn) * 4 + g) * 128 + sub * 8;
            st8(dst, x);
        }
    }
    __syncthreads();
}

DI void nsa_gates(int L2, char* lds, int vcu, int G, int wave, int lane) {
    unsigned char* const wsb = arg_ws();
    const int j16 = lane & 15, q4 = lane >> 4, kp = wave & 1, pr = wave >> 1;
    float* part = (float*)lds + (pr & 1) * (24 * 64);
    for (int base = 0; base < M / 32; base += 2 * G) {
        if (base == 0) {
            const int s0 = wave >= 4 ? (wave - 4) * 3 : 12 + wave, ns = wave >= 4 ? 3 : 1;
#pragma unroll 1
            for (int sl = 0; sl < ns; ++sl) nsa_normrope(L2, vcu * 16 + s0 + sl, G * 16, lane);
        }
        const int it = base + pr * G + vcu; const bool valid = wave < 4 && it < M / 32;
        const int row0 = it * 32;
        f32x4 c[2][3];
#pragma unroll
        for (int rb = 0; rb < 2; ++rb)
#pragma unroll
            for (int cb = 0; cb < 3; ++cb) c[rb][cb] = (f32x4){0.f, 0.f, 0.f, 0.f};
        if (valid) {
            const bf16_t* hb = (const bf16_t*)(wsb + WS_HB); const bf16_t* wg = (const bf16_t*)(wsb + WS_WG + (size_t)L2 * SZ_WG);
            const bf16_t* hp = hb + (size_t)(row0 + j16) * 256 + q4 * 8;
            const bf16_t* wp = wg + (size_t)j16 * DM + q4 * 8;
#pragma unroll 4
            for (int kk = 0; kk < DM / 64; ++kk) { const int ks = kp * (DM / 64) + kk;
                const bf16_t* hk = hp + (size_t)(ks >> 3) * ((size_t)M * 256) + (ks & 7) * 32;
                const bf16x8 h0 = *(const GAS bf16x8*)hk, h1 = *(const GAS bf16x8*)(hk + 16 * 256);
                const bf16x8 w0 = *(const GAS bf16x8*)(wp + ks * 32), w1 = *(const GAS bf16x8*)(wp + (size_t)16 * DM + ks * 32), w2 = *(const GAS bf16x8*)(wp + (size_t)32 * DM + ks * 32);
                c[0][0] = __builtin_amdgcn_mfma_f32_16x16x32_bf16(w0, h0, c[0][0], 0, 0, 0); c[0][1] = __builtin_amdgcn_mfma_f32_16x16x32_bf16(w1, h0, c[0][1], 0, 0, 0); c[0][2] = __builtin_amdgcn_mfma_f32_16x16x32_bf16(w2, h0, c[0][2], 0, 0, 0);
                c[1][0] = __builtin_amdgcn_mfma_f32_16x16x32_bf16(w0, h1, c[1][0], 0, 0, 0); c[1][1] = __builtin_amdgcn_mfma_f32_16x16x32_bf16(w1, h1, c[1][1], 0, 0, 0); c[1][2] = __builtin_amdgcn_mfma_f32_16x16x32_bf16(w2, h1, c[1][2], 0, 0, 0);
            }
            if (kp) {
#pragma unroll
                for (int rb = 0; rb < 2; ++rb)
#pragma unroll
                    for (int cb = 0; cb < 3; ++cb)
#pragma unroll
                        for (int e = 0; e < 4; ++e) part[((rb * 3 + cb) * 4 + e) * 64 + lane] = c[rb][cb][e];
            }
        }
        __syncthreads();
        if (valid && kp == 0) {
            const float* rowss = (const float*)(wsb + WS_ROWSS); float* gates = (float*)(wsb + WS_GATES);
#pragma unroll
            for (int rb = 0; rb < 2; ++rb) {
                float s = 0.f;
#pragma unroll
                for (int q = 0; q < 8; ++q) s += ((const GAS float*)rowss)[(size_t)(q4 * 8 + q) * M + row0 + rb * 16 + j16];
                s = sum_xor32(sum_xor16(s));
                const float rs = __builtin_amdgcn_rsqf(s * (1.0f / DM) + EPS);
#pragma unroll
                for (int cb = 0; cb < 3; ++cb) { f32x4 v;
#pragma unroll
                    for (int e = 0; e < 4; ++e) v[e] = (c[rb][cb][e] + part[((rb * 3 + cb) * 4 + e) * 64 + lane]) * rs;
                    *(GAS f32x4*)(gates + (size_t)(row0 + rb * 16 + j16) * 48 + cb * 16 + 4 * q4) = v; }
            }
        }
        __syncthreads();
    }
}

struct MaskCmp { int t; DI bool ok(int, int n) const { return 16 * n + 31 <= t; } DI bool partial(int) const { return true; } DI bool rowok(int) const { return true; } };
struct MaskSel { int t, qt; unsigned long long sel;
    DI bool ok(int, int key) const { return key <= t; }
    DI bool partial(int j) const { return j >= qt; }
    DI bool rowok(int j) const { return ((sel >> j) & 1ull) != 0ull; } };
struct SeqBits { unsigned long long bits; DI bool first(int& j) const { if (!bits) return false; j = __builtin_ctzll(bits); return true; }
    DI bool next(int j, int& jn) const { const unsigned long long rest = j >= 63 ? 0ull : (bits >> (j + 1)); if (!rest) return false; jn = j + 1 + __builtin_ctzll(rest); return true; } };
constexpr int NSL_KV = 0, NSL_OST = 65536, NSL_IMP = 135168, NSL_WS = 151552, NSL_SEL = 153600;
static_assert(NSL_OST + 8 * 32 * 136 * 2 <= NSL_IMP && NSL_IMP + 8 * 2048 <= NSL_WS && NSL_SEL + 512 <= MISC_OFF, "nsa LDS map");
DI void nsa_stage_out(att::Core<128>& c, bf16_t* stg, float* ws, float fac, bool first, int r32, int hi) {
    if (hi == 0) ws[r32] = fac;
    LDS_WAIT();
#pragma unroll
    for (int r = 0; r < 16; ++r) { const int orow = att::crow(r, hi); const float f = ws[orow];
#pragma unroll
        for (int d0 = 0; d0 < 4; ++d0) { bf16_t* p = stg + orow * 136 + d0 * 32 + r32; float v = c.o[d0][r] * f; if (!first) v += bf2f(*p); *p = f2bf1(v); } }
    LDS_WAIT();
}
DI void nsa_attention(int L2, char* lds, int vcu, int G, int tid, int wave, int lane) {
#define NSA_QKV ((const bf16_t*)(arg_ws() + WS_ACT))
#define NSA_KC ((const bf16_t*)(arg_ws() + WS_KC))
#define NSA_VC ((const bf16_t*)(arg_ws() + WS_VC))
    const int r32 = lane & 31, hi = lane >> 5, tl = r32 >> 2, r = r32 & 3;
    float* ws = (float*)(lds + NSL_WS) + wave * 64;
    bf16_t* stg = (bf16_t*)(lds + NSL_OST) + wave * (32 * 136);
    float* imp = (float*)(lds + NSL_IMP) + wave * 512;
    unsigned long long* selm = (unsigned long long*)(lds + NSL_SEL);
    constexpr float C = 0.088388347648318440f * 1.4426950408889634f;
    const int nper = (G == 256) ? 4 : (1024 + G - 1) / G;
    for (int ui = 0; ui < nper; ++ui) {
        int bg, qt;
        if (G == 256) { const int s = vcu & 15; bg = vcu >> 4; qt = ui == 0 ? s : (ui == 1 ? 31 - s : (ui == 2 ? 32 + s : 63 - s)); }
        else { const int u = ui * G + vcu; if (u >= 1024) break; bg = u >> 6; qt = u & 63; }
        const int b = bg >> 2, g = bg & 3, t0 = qt * 64, t = t0 + 8 * wave + tl, h = 4 * g + r;
        const bf16_t* rowp = NSA_QKV + (size_t)(b * T + t) * NS_N;
        att::Core<128> c;
        att::load_q<128>(c, rowp + h * 128, hi);
        qnorm_rope<128>(c, arg_in<15>() + L2 * 128, (const float*)(arg_ws() + WS_ROPE128) + (size_t)(b * T + t) * 32, hi);
#define NSA_GATE(k_) sigmoidf_(((const GAS float*)(arg_ws() + WS_GATES))[(size_t)(b * T + t) * 48 + h + 16 * (k_)])
        const int ncmp_tiles = (4 * qt + 3 + 63) >> 6;
        {
            att::core_reset<128>(c, att::M_INIT, 0.f);
            SeqRange seq; seq.lo = 0; seq.hi = ncmp_tiles - 1;
            MaskCmp mk; mk.t = t;
            att::run_tiles<128, false>(c, lds + NSL_KV, ws, NSA_KC + (size_t)b * 256 * 512 + g * 128, NSA_VC + (size_t)b * 256 * 512 + g * 128, 512, seq, mk, KxNone(), tid, lane);
            const bool has = (t >= 31) && c.l_reg > 0.f;
            nsa_stage_out(c, stg, ws, has ? NSA_GATE(0) * fast_rcp(c.l_reg) : 0.f, true, r32, hi);
        }
        unsigned long long mysel, usel;
        if (qt < 16) { mysel = (2ull << qt) - 1ull; usel = mysel; }
        else {
            const float inv_l = (c.l_reg > 0.f) ? fast_rcp(c.l_reg) : 0.f, mC = -c.m_reg * C;
            float carry = 0.f;
            for (int j = 0; j < ncmp_tiles; ++j) {
                att::StgH<128> s; att::stg_ld<128>(s, NSA_KC + (size_t)(b * 256 + 64 * j) * 512 + g * 128, 512, tid);
                __syncthreads();
                att::stg_wrK<128>(s, lds + NSL_KV, tid);
                __syncthreads();
                f32x16 p0, p1; att::qkt<128>(p0, p1, lds + NSL_KV, c.qr, r32, hi);
#pragma unroll
                for (int q = 0; q < 16; ++q) { const int n = 64 * j + att::crow(q, hi);
                    p0[q] = (16 * n + 31 <= t) ? fast_exp2(fmaf(p0[q], C, mC)) * inv_l : 0.f;
                    p1[q] = (16 * (n + 32) + 31 <= t) ? fast_exp2(fmaf(p1[q], C, mC)) * inv_l : 0.f; }
                float own0[4], own1[4], pl0[4], pl1[4];
#pragma unroll
                for (int q = 0; q < 4; ++q) { own0[q] = (p0[4 * q] + p0[4 * q + 1]) + (p0[4 * q + 2] + p0[4 * q + 3]); own1[q] = (p1[4 * q] + p1[4 * q + 1]) + (p1[4 * q + 2] + p1[4 * q + 3]);
                    pl0[q] = __shfl_xor(p0[4 * q + 3], 32); pl1[q] = __shfl_xor(p1[4 * q + 3], 32); }
                if (hi == 1) {
#pragma unroll
                    for (int q = 0; q < 4; ++q) { own0[q] += pl0[q]; own1[q] += pl1[q]; }
                } else {
                    own0[0] += carry; own1[0] += pl0[3];
#pragma unroll
                    for (int q = 1; q < 4; ++q) { own0[q] += pl0[q - 1]; own1[q] += pl1[q - 1]; }
                    carry = pl1[3];
                }
#pragma unroll
                for (int q = 0; q < 4; ++q) { own0[q] += __shfl_xor(own0[q], 1); own0[q] += __shfl_xor(own0[q], 2); own1[q] += __shfl_xor(own1[q], 1); own1[q] += __shfl_xor(own1[q], 2); }
                if (r == 0) {
#pragma unroll
                    for (int q = 0; q < 4; ++q) { imp[tl * 64 + 16 * j + 2 * q + hi] = own0[q]; imp[tl * 64 + 16 * j + 8 + 2 * q + hi] = own1[q]; }
                }
            }
            LDS_WAIT();
            const int tk = lane >> 3, sub = lane & 7;
            float v[8]; int cnt[8];
#pragma unroll
            for (int e = 0; e < 8; ++e) { v[e] = imp[tk * 64 + 8 * e + sub]; cnt[e] = 0; }
            for (int J2 = 1; J2 <= qt - 2; ++J2) { const float x = imp[tk * 64 + J2];
#pragma unroll
                for (int e = 0; e < 8; ++e) { const int J = 8 * e + sub; cnt[e] += (x > v[e] || (x == v[e] && J2 < J)) ? 1 : 0; } }
            unsigned long long m64 = 0ull;
#pragma unroll
            for (int e = 0; e < 8; ++e) { const int J = 8 * e + sub;
                const bool sel = (J == 0) || (J == qt) || (J == qt - 1) || (J >= 1 && J <= qt - 2 && cnt[e] < 13);
                const unsigned long long bal = __ballot(sel);
                m64 |= ((bal >> (8 * tk)) & 0xffull) << (8 * e); }
            if (sub == 0) selm[wave * 8 + tk] = m64;
            __syncthreads();
            mysel = selm[wave * 8 + tl];
            unsigned long long uu = selm[lane];
#pragma unroll
            for (int o = 1; o < 64; o <<= 1) { const unsigned lo_ = __shfl_xor((unsigned)uu, o), hi_ = __shfl_xor((unsigned)(uu >> 32), o); uu |= ((unsigned long long)hi_ << 32) | lo_; }
            usel = ((unsigned long long)__builtin_amdgcn_readfirstlane((unsigned)(uu >> 32)) << 32) | (unsigned)__builtin_amdgcn_readfirstlane((unsigned)uu);
        }
        {
            att::core_reset<128>(c, att::M_INIT, 0.f);
            SeqBits seq; seq.bits = usel;
            MaskSel mk; mk.t = t; mk.qt = qt; mk.sel = mysel;
            att::run_tiles<128, false>(c, lds + NSL_KV, ws, NSA_QKV + (size_t)b * T * NS_N + NS_KS + g * 128, NSA_QKV + (size_t)b * T * NS_N + NS_VS + g * 128, NS_N, seq, mk, KxNone(), tid, lane);
            nsa_stage_out(c, stg, ws, NSA_GATE(1) * fast_rcp(c.l_reg), false, r32, hi);
        }
        {
            att::core_reset<128>(c, att::M_INIT, 0.f);
            SeqRange seq; seq.lo = qt - 8 < 0 ? 0 : qt - 8; seq.hi = qt;
            MaskWin mk; mk.t = t; mk.w = 512; mk.tmin = t0; mk.tmax = t0 + 63;
            att::run_tiles<128, false>(c, lds + NSL_KV, ws, NSA_QKV + (size_t)b * T * NS_N + NS_KW + g * 128, NSA_QKV + (size_t)b * T * NS_N + NS_VW + g * 128, NS_N, seq, mk, KxNone(), tid, lane);
            nsa_stage_out(c, stg, ws, NSA_GATE(2) * fast_rcp(c.l_reg), false, r32, hi);
        }
#pragma unroll
        for (int i = 0; i < 8; ++i) { const int row = i * 4 + (lane >> 4), ch = lane & 15; const u32x4 v = *(const u32x4*)(stg + row * 136 + ch * 8);
            *(GAS u32x4*)((bf16_t*)(arg_ws() + WS_OB) + (size_t)(b * T + t0 + 8 * wave + (row >> 2)) * DM + (4 * g + (row & 3)) * 128 + ch * 8) = v; }
        LDS_WAIT();
        __syncthreads();
    }
}

#define GRID_BAR() do { XcdBarrier bar_; bar_.bar = (unsigned*)(arg_ws() + WS_CTL) + CW_BAR; bar_.x = xb_xcc_id(); bar_.st = (volatile LAS unsigned*)((LAS unsigned char*)lds + MISC_OFF) + 8; xcd_barrier(bar_, wave_s == 0 && lane_id_v() == 0); } while (0)
#define LIGHT_BAR() do { XcdBarrier bar_; bar_.bar = (unsigned*)(arg_ws() + WS_CTL) + CW_BAR; bar_.x = xb_xcc_id(); bar_.st = (volatile LAS unsigned*)((LAS unsigned char*)lds + MISC_OFF) + 8; if (((volatile LAS unsigned*)((LAS unsigned char*)lds + MISC_OFF))[12]) xcd_barrier_local(bar_, wave_s == 0 && lane_id_v() == 0); else xcd_barrier(bar_, wave_s == 0 && lane_id_v() == 0); } while (0)
__global__ void __launch_bounds__(NWAVES * 64, 2) fwd_kernel(Args args) {
    extern __shared__ __attribute__((aligned(16))) unsigned char lds[];
    LAS unsigned char* ldsl = (LAS unsigned char*)lds;
    const int wave_s = __builtin_amdgcn_readfirstlane((int)threadIdx.x >> 6);
    {
        const int tid = threadIdx.x;
        volatile LAS unsigned* MISC = (volatile LAS unsigned*)(ldsl + MISC_OFF);
        for (int u = tid; u < (LDS_BYTES - MISC_OFF) / 4; u += NWAVES * 64) MISC[u] = 0u;
        __syncthreads();
        (void)xcd_barrier_post((unsigned*)(arg_ws() + WS_CTL) + CW_BAR, MISC + 8);
        { int bxs = blockIdx.x; asm volatile("" : "+s"(bxs)); if (tid == 0) __hip_atomic_store((unsigned*)(arg_ws() + WS_CTL + 8192) + bxs, xb_xcc_id() + 1u, __ATOMIC_RELAXED, __HIP_MEMORY_SCOPE_AGENT); }
    }
#define TIDV int tid_ = wave_s * 64 + lane_id_v(); asm volatile("" : "+v"(tid_)); int G_ = gridDim.x, bx_ = blockIdx.x; asm volatile("" : "+s"(G_), "+s"(bx_)); const int tid = tid_, lane = tid & 63, wave = __builtin_amdgcn_readfirstlane(tid >> 6); const int G = G_, bx = bx_, vcu = (G % 8 == 0) ? (bx % 8) * (G / 8) + bx / 8 : bx; (void)tid; (void)lane; (void)wave; (void)vcu
#ifndef NO_PRO
    { TIDV; prologue(ldsl, vcu, G, wave, lane); }
#endif
    GRID_BAR();
    {
        unsigned* xt = (unsigned*)(arg_ws() + WS_CTL + 8192);
        int G = gridDim.x; asm volatile("" : "+s"(G)); int ok = (G % 8 == 0) ? 1 : 0;
        const int t_ = wave_s * 64 + lane_id_v();
        for (int b = t_; b < G; b += NWAVES * 64) { const unsigned e = xb_ld(&xt[b]), e0 = xb_ld(&xt[b & 7]); ok &= (e == e0 && e != 0u) ? 1 : 0; }
        {
            volatile LAS unsigned* MISC = (volatile LAS unsigned*)(ldsl + MISC_OFF);
            const unsigned wok = __all(ok) ? 1u : 0u;
            if (lane_id_v() == 0) MISC[16 + wave_s] = wok;
            __syncthreads();
            if (t_ == 0) { unsigned a = 1u; for (int w = 0; w < NWAVES; ++w) a &= MISC[16 + w]; MISC[12] = a; }
            __syncthreads();
        }
    }

    int stage = 0;
    for (int hl = 0; hl < 2 * DEPTH; ++hl) {
        if (stage < NSTAGES) {
#ifndef NO_S1
            {
                unsigned char* ws = arg_ws();
                pg8::Gemm g{(const bf16_t*)(ws + WS_HB), (const bf16_t*)(ws + WS_WFI + (size_t)hl * SZ_WFI), M, NFF, DM};
                pg8::StaticOrder S; { int G_ = gridDim.x, bx_ = blockIdx.x; asm volatile("" : "+s"(G_), "+s"(bx_)); S.init(M, NFF, G_, bx_); }
                pg8::cached_rs_reset(wave_s);
                pg8::EpiSwiGLU E{(bf16_t*)(ws + WS_ACT), (const float*)(ws + WS_ROWSS)};
                pg8::gemm_phase<pg8::EpiSwiGLU, pg8::StaticOrder, DM, true, true, true>(ldsl, g, S, E, wave_s);
            }
#endif
            GRID_BAR();
#ifndef NO_S2
            {
                unsigned char* ws = arg_ws(); float* out = (stage == 3 * DEPTH - 1) ? arg_out() : nullptr;
                pg8::Gemm g{(const bf16_t*)(ws + WS_ACT), (const bf16_t*)(ws + WS_WFO + (size_t)hl * SZ_WFO), M, DM, DFF};
                pg8::StaticOrder S; { int G_ = gridDim.x, bx_ = blockIdx.x; asm volatile("" : "+s"(G_), "+s"(bx_)); S.init(M, DM, G_, bx_); }
                pg8::EpiResid E{(bf16_t*)(ws + WS_HB), (bf16_t*)(ws + WS_LB), out, (float*)(ws + WS_ROWSS), 0.5f};
                pg8::gemm_phase<pg8::EpiResid, pg8::StaticOrder, DFF, false, true>(ldsl, g, S, E, wave_s);
            }
#endif
            GRID_BAR();
        }
        ++stage;
        if ((hl & 1) == 0) {
            if (stage < NSTAGES) {
                const int L = hl >> 1, L2 = L >> 1; const bool swa = (L & 1) == 0;
#ifndef NO_S3
                {
                    unsigned char* ws = arg_ws();
                    const int N = swa ? SW_N : NS_N;
                    pg8::Gemm g{(const bf16_t*)(ws + WS_HB), (const bf16_t*)(swa ? ws + WS_WSI + (size_t)L2 * SZ_WSI : ws + WS_WNI + (size_t)L2 * SZ_WNI), M, N, DM};
                    pg8::StaticOrder S; { int G_ = gridDim.x, bx_ = blockIdx.x; asm volatile("" : "+s"(G_), "+s"(bx_)); S.init(M, N, G_, bx_); }
                    pg8::cached_rs_reset(wave_s);
                    pg8::EpiScaleBf16 E{(bf16_t*)(ws + WS_ACT), N, (const float*)(ws + WS_ROWSS)};
                    pg8::gemm_phase<pg8::EpiScaleBf16, pg8::StaticOrder, DM, true, true, true>(ldsl, g, S, E, wave_s);
                }
                if (swa) { TIDV;
                    const int nun = (M / 256) * (SW_N / 256), maxu = (nun + G - 1) / G, b0 = nun - (maxu - 1) * G;
                    if (b0 >= G) convert_deferred(ldsl, L2, bx, G, wave, lane);
                    else if (bx >= b0) convert_deferred(ldsl, L2, bx - b0, G - b0, wave, lane);
                }
#endif
                GRID_BAR();
                if (swa) {
#ifndef NO_SWA
                    { TIDV; swa_attention(L2, (char*)lds, vcu, G, tid, wave, lane); }
#endif
                } else {
#ifndef NO_NSAC
                    { TIDV; nsa_compress(L2, (char*)lds, vcu, G, tid, wave, lane);
                      nsa_gates(L2, (char*)lds, vcu, G, wave, lane); }
#endif
                    GRID_BAR();
#ifndef NO_NSAA
                    { TIDV; nsa_attention(L2, (char*)lds, vcu, G, tid, wave, lane); }
#endif
                }
                GRID_BAR();
#ifndef NO_S4
                {
                    unsigned char* ws = arg_ws();
                    pg8::Gemm g{(const bf16_t*)(ws + WS_OB), (const bf16_t*)(swa ? ws + WS_WSO + (size_t)L2 * SZ_WO : ws + WS_WNO + (size_t)L2 * SZ_WO), M, DM, DM};
                    pg8::StaticOrder S; { int G_ = gridDim.x, bx_ = blockIdx.x; asm volatile("" : "+s"(G_), "+s"(bx_)); S.init(M, DM, G_, bx_); }
                    pg8::EpiResid E{(bf16_t*)(ws + WS_HB), (bf16_t*)(ws + WS_LB), nullptr, (float*)(ws + WS_ROWSS), 1.0f};
                    pg8::gemm_phase<pg8::EpiResid, pg8::StaticOrder, DM, false, true>(ldsl, g, S, E, wave_s);
                }
#endif
                GRID_BAR();
            }
            ++stage;
        }
    }
    (void)args;
}

extern "C" void kernel_launch(void* const* d_in, const int* in_sizes, int n_in, void* d_out, int out_size, void* d_ws, size_t ws_size, hipStream_t stream) {
    static int grid = 0;
    if (grid == 0) {
        if (n_in != 24 || in_sizes[0] != M * DM || out_size != M * DM || ws_size < WS_END) {
            fprintf(stderr, "kernel_launch: shape mismatch n_in %d in0 %d out %d ws %zu (need %zu)\n", n_in, n_in > 0 ? in_sizes[0] : -1, out_size, ws_size, (size_t)WS_END); grid = -1; return; }
        int dev = 0, cus = 0;
        if (hipGetDevice(&dev) != hipSuccess || hipDeviceGetAttribute(&cus, hipDeviceAttributeMultiprocessorCount, dev) != hipSuccess) { grid = -1; return; }
        if (hipFuncSetAttribute((const void*)fwd_kernel, hipFuncAttributeMaxDynamicSharedMemorySize, LDS_BYTES) != hipSuccess) { fprintf(stderr, "kernel_launch: hipFuncSetAttribute failed\n"); grid = -1; return; }
        int per_cu = 0;
        if (hipOccupancyMaxActiveBlocksPerMultiprocessor(&per_cu, (const void*)fwd_kernel, NWAVES * 64, LDS_BYTES) != hipSuccess || per_cu < 1) {
            fprintf(stderr, "kernel_launch: occupancy query reports %d workgroups per CU\n", per_cu); }
        (void)hipGetLastError();
        grid = cus;
    }
    if (grid < 0) return;
    if (hipMemsetAsync((char*)d_ws + WS_CTL, 0, CTL_ZERO_BYTES, stream) != hipSuccess) return;
    Args a{};
    for (int i = 0; i < 24; ++i) a.in[i] = (const float*)d_in[i];
    a.out = (float*)d_out; a.ws = (unsigned char*)d_ws;
    hipLaunchKernelGGL(fwd_kernel, dim3(grid), dim3(NWAVES * 64), LDS_BYTES, stream, a);
    const hipError_t le = hipPeekAtLastError();
    if (le != hipSuccess) fprintf(stderr, "kernel_launch: launch failed: %s\n", hipGetErrorName(le));
}
```

```cpp
#include <hip/hip_runtime.h>
#include <cstdio>
#include <cstdint>

#define DI __device__ __forceinline__
#define GAS __attribute__((address_space(1)))
#define LAS __attribute__((address_space(3)))

#ifndef RES_LO
#define RES_LO 0
#endif
#ifndef NSTAGES
#define NSTAGES 12
#endif

typedef unsigned short bf16_t;
typedef short bf16x8 __attribute__((ext_vector_type(8)));
typedef short s16x4 __attribute__((ext_vector_type(4)));
typedef float f32x4 __attribute__((ext_vector_type(4)));
typedef float f32x2 __attribute__((ext_vector_type(2)));
typedef float f32x16 __attribute__((ext_vector_type(16)));
typedef unsigned u32x4 __attribute__((ext_vector_type(4)));
typedef unsigned u32x2 __attribute__((ext_vector_type(2)));

constexpr int NB = 4, T = 4096, DM = 2048, M = NB * T, DFF = 5632, NFF = 2 * DFF, DEPTH = 4;
constexpr int SW_N = 2560;
constexpr int NS_NREAL = 5168, NS_N = 5120;
constexpr int NS_KC = 2048, NS_VC = 2560, NS_KS = 3072, NS_VS = 3584, NS_KW = 4096, NS_VW = 4608;
constexpr float EPS = 1e-6f;

constexpr size_t MiB = 1u << 20;
constexpr size_t al(size_t x) { return (x + MiB - 1) / MiB * MiB; }
constexpr size_t WS_CTL = 0, CTL_ZERO_BYTES = 32768;
constexpr size_t SZ_WFI = (size_t)NFF * DM * 2, SZ_WFO = (size_t)DM * DFF * 2, SZ_WSI = (size_t)SW_N * DM * 2, SZ_WO = (size_t)DM * DM * 2, SZ_WNI = (size_t)NS_N * DM * 2;
constexpr size_t SZ_W1 = (size_t)256 * 4096 * 2, SZ_W2 = (size_t)128 * 256 * 2, SZ_BIASP = (size_t)32 * 256 * 4;
constexpr size_t WS_WFI = 1 * MiB;
constexpr size_t WS_WFO = al(WS_WFI + 8 * SZ_WFI);
constexpr size_t WS_WSI = al(WS_WFO + 8 * SZ_WFO);
constexpr size_t WS_WSO = al(WS_WSI + 2 * SZ_WSI);
constexpr size_t WS_WNI = al(WS_WSO + 2 * SZ_WO);
constexpr size_t WS_WNO = al(WS_WNI + 2 * SZ_WNI);
constexpr size_t WS_W1 = al(WS_WNO + 2 * SZ_WO);
constexpr size_t WS_W2 = al(WS_W1 + 4 * SZ_W1);
constexpr size_t WS_BIASP = WS_W2 + 4 * SZ_W2;
constexpr size_t WS_ROPE64 = al(WS_BIASP + 4 * SZ_BIASP);
constexpr size_t WS_ROPE128 = al(WS_ROPE64 + (size_t)M * 16 * 4);
constexpr size_t WS_HB = al(WS_ROPE128 + (size_t)M * 32 * 4);
constexpr size_t WS_LB = al(WS_HB + (size_t)M * DM * 2);
constexpr size_t WS_ROWSS = al(WS_LB + (size_t)M * DM * 2);
constexpr size_t WS_ACT = al(WS_ROWSS + (size_t)M * 32 * 4);
constexpr size_t WS_OB = al(WS_ACT + (size_t)M * DFF * 2);
constexpr size_t WS_KC = al(WS_OB + (size_t)M * DM * 2);
constexpr size_t WS_VC = WS_KC + 1 * MiB;
constexpr size_t WS_WG = WS_VC + 1 * MiB;
constexpr size_t SZ_WG = (size_t)64 * DM * 2;
constexpr size_t WS_GATES = WS_WG + 1 * MiB;
constexpr size_t WS_END = WS_GATES + 4 * MiB;
static_assert((size_t)M * NS_N * 2 <= (size_t)M * DFF * 2, "nsa projections fit the activation region");

constexpr int CW_BAR = 4096;

constexpr int MISC_OFF = 154624;
constexpr int LDS_BYTES = 155648;
constexpr int NWAVES = 8;

DI unsigned cvtpk(float lo, float hi) { unsigned r; asm volatile("v_cvt_pk_bf16_f32 %0, %1, %2" : "=v"(r) : "v"(lo), "v"(hi)); return r; }
DI float bf2f(unsigned short b) { return __builtin_bit_cast(float, (unsigned)b << 16); }
DI float bflo(unsigned w) { return __builtin_bit_cast(float, w << 16); }
DI float bfhi(unsigned w) { return __builtin_bit_cast(float, w & 0xffff0000u); }
DI unsigned short f2bf1(float f) { return (unsigned short)(cvtpk(f, 0.f) & 0xffffu); }
DI float fast_rcp(float x) { return __builtin_amdgcn_rcpf(x); }
DI float fast_exp2(float x) { return __builtin_amdgcn_exp2f(x); }
DI float silu(float x) { return x * fast_rcp(1.f + fast_exp2(-1.4426950408889634f * x)); }
DI float sigmoidf_(float x) { return fast_rcp(1.f + fast_exp2(-1.4426950408889634f * x)); }
DI float sum_xor16(float s) { auto r = __builtin_amdgcn_permlane16_swap(__float_as_uint(s), __float_as_uint(s), false, false); return __uint_as_float(r[0]) + __uint_as_float(r[1]); }
DI float sum_xor32(float s) { auto r = __builtin_amdgcn_permlane32_swap(__float_as_uint(s), __float_as_uint(s), false, false); return __uint_as_float(r[0]) + __uint_as_float(r[1]); }
#define LDS_WAIT() asm volatile("s_waitcnt lgkmcnt(0)" ::: "memory")
#define VM_WAIT() asm volatile("s_waitcnt vmcnt(0)" ::: "memory")

namespace pg8 {
constexpr int BM = 256, BK = 64, HALF = 128, HTB = HALF * BK * 2, STAGE_BYTES = 8 * HTB, NXCD = 8, WGM = 8;
__host__ __device__ __forceinline__ int lds_byte(int r, int c) { const int st = (r >> 4) * 2 + (c >> 5), rr = r & 15, cc = c & 31, ob = rr * 64 + cc * 2; return st * 1024 + (ob ^ (((ob >> 9) & 1) << 5)); }
__host__ __device__ __forceinline__ void stage_rc(int b, int& R, int& C) { const int st = b / 1024, sb = b % 1024, swz = sb ^ (((sb >> 9) & 1) << 5); R = (st >> 1) * 16 + swz / 64; C = (st & 1) * 32 + (swz % 64) / 2; }
__host__ __device__ __forceinline__ int perm32(int rho) { const int n = rho >> 4, i = rho & 15; return 8 * (i >> 2) + 4 * n + (i & 3); }
struct Unit { int pm, pn; };
struct Gemm { const bf16_t* A; const bf16_t* Bt; int M, N, K; };
struct StaticOrder {
    int nM, nN, nwg, G, c;
    __host__ __device__ void init(int M_, int N_, int G_, int c_) { nM = M_ / BM; nN = N_ / BM; nwg = nM * nN; G = G_; c = c_; }
    __host__ __device__ bool next(int i, Unit& u) const {
        const long L = (long)i * G + c; if (L >= nwg) return false;
        int wgid = (int)L; { const int q = nwg / NXCD, r = nwg % NXCD, xcd = wgid % NXCD, off = wgid / NXCD; wgid = (xcd < r ? xcd * (q + 1) : r * (q + 1) + (xcd - r) * q) + off; }
        const int nig = WGM * nN, gid = wgid / nig, fm = gid * WGM, gsz = (nM - fm) < WGM ? (nM - fm) : WGM;
        u.pm = fm + ((wgid % nig) % gsz); u.pn = (wgid % nig) / gsz; return true;
    }
    __device__ __forceinline__ void a_ready(const Unit&) const {}
    __device__ __forceinline__ void done(const Unit&) const {}
};

DI void load_rs(const float* rowss, int row0, int fq, float (&rs)[2][4]) {
    float a[2][4][8];
#pragma unroll
    for (int ai = 0; ai < 2; ++ai)
#pragma unroll
        for (int m = 0; m < 4; ++m)
#pragma unroll
            for (int q = 0; q < 8; ++q) a[ai][m][q] = ((const GAS float*)rowss)[(size_t)(fq * 8 + q) * M + row0 + ai * HALF + m * 16];
    asm volatile("" ::: "memory");
    float eps = EPS; asm volatile("" : "+v"(eps));
#pragma unroll
    for (int ai = 0; ai < 2; ++ai)
#pragma unroll
        for (int m = 0; m < 4; ++m) {
            float s = ((a[ai][m][0] + a[ai][m][1]) + (a[ai][m][2] + a[ai][m][3])) + ((a[ai][m][4] + a[ai][m][5]) + (a[ai][m][6] + a[ai][m][7]));
            s = sum_xor32(sum_xor16(s));
            rs[ai][m] = __builtin_amdgcn_rsqf(s * (1.0f / DM) + eps);
        }
}
constexpr int RSC_OFF = 131072, RSC_WAVE_BYTES = 1024;
DI void cached_rs(const float* rowss, int pm, int row0, int wid, int fr, int fq, float (&rs)[2][4]) {
    LAS float* slot = (LAS float*)(unsigned)(RSC_OFF + wid * RSC_WAVE_BYTES);
    const int tag = ((volatile LAS int*)slot)[0];
    if (__builtin_amdgcn_readfirstlane(tag) != pm) {
        load_rs(rowss, row0, fq, rs);
        if (fq == 0) {
#pragma unroll
            for (int ai = 0; ai < 2; ++ai)
#pragma unroll
                for (int m = 0; m < 4; ++m) slot[16 + 16 * (4 * ai + m) + fr] = rs[ai][m];
        }
        if (fq == 0 && fr == 0) ((volatile LAS int*)slot)[0] = pm;
    } else {
#pragma unroll
        for (int ai = 0; ai < 2; ++ai)
#pragma unroll
            for (int m = 0; m < 4; ++m) rs[ai][m] = slot[16 + 16 * (4 * ai + m) + fr];
    }
}
DI void cached_rs_reset() {
    const int wid = __builtin_amdgcn_readfirstlane((int)threadIdx.x >> 6);
    if ((threadIdx.x & 63) == 0) ((volatile LAS int*)(unsigned)(RSC_OFF + wid * RSC_WAVE_BYTES))[0] = -1;
}
struct EpiSwiGLU {
    static constexpr bool PERM = true, AFTER_DRAIN = false, WIDE = false;
    bf16_t* O; const float* rowss;
    DI void operator()(const f32x4 (&acc)[2][2][4][2], const Unit& u, int wr, int wc, int fr, int fq) const {
        const int row0 = u.pm * BM + wr * 64 + fr, col0 = u.pn * HALF + wc * 32 + 8 * fq;
        float rs[2][4]; cached_rs(rowss, u.pm, row0, wr * 4 + wc, fr, fq, rs);
#pragma unroll
        for (int ai = 0; ai < 2; ++ai)
#pragma unroll
            for (int m = 0; m < 4; ++m) {
                const float r = rs[ai][m], rn = -1.4426950408889634f * r, r2 = r * r;
                u32x4 w;
#pragma unroll
                for (int n = 0; n < 2; ++n)
#pragma unroll
                    for (int h2 = 0; h2 < 2; ++h2) {
                        const f32x2 g = {acc[ai][0][m][n][2 * h2], acc[ai][0][m][n][2 * h2 + 1]}, uu = {acc[ai][1][m][n][2 * h2], acc[ai][1][m][n][2 * h2 + 1]};
                        f32x2 t = g * rn; t = __builtin_elementwise_min(t, (f32x2){60.f, 60.f});
                        f32x2 d; d.x = fast_exp2(t.x); d.y = fast_exp2(t.y); d = d + 1.0f;
                        const float R = fast_rcp(d.x * d.y);
                        const f32x2 q = (f32x2){d.y, d.x} * R;
                        const f32x2 o = ((g * uu) * r2) * q;
                        const unsigned pk = cvtpk(o.x, o.y);
                        if (n == 0) { if (h2 == 0) w.x = pk; else w.y = pk; } else { if (h2 == 0) w.z = pk; else w.w = pk; }
                    }
                *(GAS u32x4*)(O + (size_t)(row0 + ai * HALF + m * 16) * DFF + col0) = w;
            }
    }
};
struct EpiScaleBf16 {
    static constexpr bool PERM = true, AFTER_DRAIN = false, WIDE = false;
    bf16_t* O; int ldc; const float* rowss;
    DI void operator()(const f32x4 (&acc)[2][2][4][2], const Unit& u, int wr, int wc, int fr, int fq) const {
        const int row0 = u.pm * BM + wr * 64 + fr, col0 = u.pn * BM + wc * 32 + 8 * fq;
        float rs[2][4]; cached_rs(rowss, u.pm, row0, wr * 4 + wc, fr, fq, rs);
#pragma unroll
        for (int ai = 0; ai < 2; ++ai)
#pragma unroll
            for (int m = 0; m < 4; ++m) {
                const float r = rs[ai][m]; bf16_t* rowp = O + (size_t)(row0 + ai * HALF + m * 16) * ldc + col0;
#pragma unroll
                for (int bj = 0; bj < 2; ++bj) { const f32x4 v0 = acc[ai][bj][m][0] * r, v1 = acc[ai][bj][m][1] * r;
                    u32x4 w; w.x = cvtpk(v0[0], v0[1]); w.y = cvtpk(v0[2], v0[3]); w.z = cvtpk(v1[0], v1[1]); w.w = cvtpk(v1[2], v1[3]);
                    *(GAS u32x4*)(rowp + bj * HALF) = w; }
            }
    }
};
struct EpiResid {
    static constexpr bool PERM = true, AFTER_DRAIN = false, WIDE = true;
    bf16_t* hi; bf16_t* lo; float* out; float* rowss; float scale;
    DI void operator()(const f32x4 (&acc)[2][2][4][2], const Unit& u, int wr, int wc, int fr, int fq) const {
        const int row0 = u.pm * BM + wr * 64 + fr, col0 = u.pn * BM + wc * 64 + 8 * fq;
        const size_t hbase = (size_t)u.pn * ((size_t)M * 256) + wc * 64 + 8 * fq;
        u32x4 H[2][4][2];
#pragma unroll
        for (int ai = 0; ai < 2; ++ai)
#pragma unroll
            for (int m = 0; m < 4; ++m)
#pragma unroll
                for (int bj = 0; bj < 2; ++bj) H[ai][m][bj] = *(const GAS u32x4*)(hi + hbase + (size_t)(row0 + ai * HALF + m * 16) * 256 + bj * 32);
        asm volatile("" ::: "memory");
#pragma unroll
        for (int ai = 0; ai < 2; ++ai) {
#pragma unroll
            for (int m = 0; m < 4; ++m) {
                const int r = row0 + ai * HALF + m * 16; const size_t off = (size_t)r * DM + col0; float ss = 0.f;
#pragma unroll
                for (int bj = 0; bj < 2; ++bj) {
                    const u32x4 h = H[ai][m][bj];
                    const f32x4 a0 = acc[ai][bj][m][0], a1 = acc[ai][bj][m][1];
                    float v[8];
                    v[0] = bflo(h.x) + a0[0] * scale; v[1] = bfhi(h.x) + a0[1] * scale;
                    v[2] = bflo(h.y) + a0[2] * scale; v[3] = bfhi(h.y) + a0[3] * scale;
                    v[4] = bflo(h.z) + a1[0] * scale; v[5] = bfhi(h.z) + a1[1] * scale;
                    v[6] = bflo(h.w) + a1[2] * scale; v[7] = bfhi(h.w) + a1[3] * scale;
#pragma unroll
                    for (int e = 0; e < 8; ++e) ss += v[e] * v[e];
                    u32x4 nh;
                    nh.x = cvtpk(v[0], v[1]); nh.y = cvtpk(v[2], v[3]); nh.z = cvtpk(v[4], v[5]); nh.w = cvtpk(v[6], v[7]);
                    *(GAS u32x4*)(hi + hbase + (size_t)r * 256 + bj * 32) = nh;
                    if (out) { *(GAS f32x4*)(out + off + bj * 32) = (f32x4){v[0], v[1], v[2], v[3]}; *(GAS f32x4*)(out + off + bj * 32 + 4) = (f32x4){v[4], v[5], v[6], v[7]}; }
                }
                ss = sum_xor32(sum_xor16(ss));
                if (fq == 0) ((GAS float*)rowss)[(size_t)(u.pn * 4 + wc) * M + r] = ss;
            }
        }
    }
};

template <class Epi, class Sched, int KC, bool ALIGN_EPI = false, bool SP2 = false, bool ATILED = false>
__device__ __forceinline__ void gemm_phase(LAS unsigned char* lds, const Gemm g, const Sched& S, const Epi& E) {
    int tid_ = threadIdx.x; asm volatile("" : "+v"(tid_));
    const int tid = tid_, wid = __builtin_amdgcn_readfirstlane(tid >> 6), lane = tid & 63, wr = wid >> 2, wc = wid & 3, fr = lane & 15, fq = lane >> 4;
    constexpr int K = KC, nt = K / BK;
    unsigned voffA[2], voffB[2];
#pragma unroll
    for (int i = 0; i < 2; ++i) { int R, C; stage_rc(tid * 16 + i * 8192, R, C);
        const int Rb = Epi::WIDE ? (64 * (R >> 5) + perm32(R & 31)) : (Epi::PERM ? ((R & ~31) + perm32(R & 31)) : R);
        voffA[i] = ATILED ? (unsigned)(R * 256 + C) * 2u : (unsigned)(R * K + C) * 2u; voffB[i] = (unsigned)(Rb * K + C) * 2u; }
    const size_t kstep = (size_t)(BK * 2);
    const size_t hstep = (size_t)HALF * K * 2;
    const size_t hstepB = Epi::WIDE ? (size_t)32 * K * 2 : hstep;
    const size_t tstep = 2 * hstep;
    const size_t hstepA = ATILED ? (size_t)HALF * 512 : hstep, tstepA = 2 * hstepA;
    const size_t panelA = (size_t)g.M * 512;
#define PG8_AOFF(t_) (ATILED ? (size_t)((t_) >> 2) * panelA + (size_t)((t_) & 3) * kstep : (size_t)(t_) * kstep)
    const unsigned ldsw = (unsigned)wid * 1024u;
    const int aoff = lds_byte(wr * 64 + fr, fq * 8), boff = lds_byte(wc * 32 + fr, fq * 8);
#define PG8_SA(b, h) (((b) * 2 + (h)) * HTB)
#define PG8_SB(b, h) ((4 + (b) * 2 + (h)) * HTB)
#define PG8_STAGE(bufoff, gbase, voff) do { _Pragma("unroll") for (int _i = 0; _i < 2; ++_i) \
        __builtin_amdgcn_global_load_lds((const unsigned*)((const char*)(gbase) + (voff)[_i]), (LAS unsigned*)(lds + (bufoff) + ldsw + _i * 8192), 16, 0, 0); } while (0)
#define PG8_LDA(dst, b, h) do { _Pragma("unroll") for (int m = 0; m < 4; ++m) _Pragma("unroll") for (int k = 0; k < 2; ++k) dst[m][k] = *(const LAS bf16x8*)(lds + PG8_SA(b, h) + aoff + m * 2048 + k * 1024); } while (0)
#define PG8_LDB(dst, b, h) do { _Pragma("unroll") for (int n = 0; n < 2; ++n) _Pragma("unroll") for (int k = 0; k < 2; ++k) dst[n][k] = *(const LAS bf16x8*)(lds + PG8_SB(b, h) + boff + n * 2048 + k * 1024); } while (0)
#define PG8_MMA(ai, bj, At, Bt) do { __builtin_amdgcn_s_setprio(1); _Pragma("unroll") for (int m = 0; m < 4; ++m) _Pragma("unroll") for (int n = 0; n < 2; ++n) _Pragma("unroll") for (int k = 0; k < 2; ++k) \
        acc[ai][bj][m][n] = __builtin_amdgcn_mfma_f32_16x16x32_bf16(Bt[n][k], At[m][k], acc[ai][bj][m][n], 0, 0, 0); __builtin_amdgcn_s_setprio(0); } while (0)
#define PG8_WAIT_V(n) asm volatile("s_waitcnt vmcnt(" #n ")" ::: "memory")
#define PG8_WAIT_L(n) asm volatile("s_waitcnt lgkmcnt(" #n ")" ::: "memory")
#define PG8_BAR __builtin_amdgcn_s_barrier()
#define PG8_SCHED __builtin_amdgcn_sched_barrier(0)
    Unit cur, nxt; int ui = 0;
    if (!S.next(0, cur)) return;
    f32x4 acc[2][2][4][2];
#pragma unroll
    for (int a = 0; a < 2; ++a)
#pragma unroll
        for (int b = 0; b < 2; ++b)
#pragma unroll
            for (int m = 0; m < 4; ++m)
#pragma unroll
                for (int n = 0; n < 2; ++n) acc[a][b][m][n] = (f32x4){0.f, 0.f, 0.f, 0.f};
    bf16x8 At[4][2], B0[2][2], B1[2][2];
    const char* cA = (const char*)g.A + (size_t)cur.pm * tstepA; const char* cB = (const char*)g.Bt + (size_t)cur.pn * tstep;
    S.a_ready(cur);
    if constexpr (SP2) {
        PG8_STAGE(PG8_SB(0, 0), cB, voffB); PG8_STAGE(PG8_SB(0, 1), cB + hstepB, voffB); PG8_STAGE(PG8_SA(0, 0), cA, voffA); PG8_STAGE(PG8_SA(0, 1), cA + hstepA, voffA);
        if (wr == 1) PG8_BAR;
        PG8_WAIT_V(2); PG8_BAR;
        PG8_STAGE(PG8_SB(1, 0), cB + kstep, voffB); PG8_STAGE(PG8_SA(1, 0), cA + kstep, voffA); PG8_STAGE(PG8_SB(1, 1), cB + hstepB + kstep, voffB);
        PG8_WAIT_V(6); PG8_BAR;
    } else {
        PG8_STAGE(PG8_SB(0, 0), cB, voffB); PG8_STAGE(PG8_SA(0, 0), cA, voffA); PG8_STAGE(PG8_SB(0, 1), cB + hstepB, voffB); PG8_STAGE(PG8_SA(0, 1), cA + hstepA, voffA);
        if (wr == 1) PG8_BAR;
        PG8_WAIT_V(4); PG8_BAR;
        PG8_STAGE(PG8_SB(1, 0), cB + kstep, voffB); PG8_STAGE(PG8_SA(1, 0), cA + kstep, voffA); PG8_STAGE(PG8_SB(1, 1), cB + hstepB + kstep, voffB);
        PG8_WAIT_V(6); PG8_BAR;
    }
    for (;;) {
        const bool has_next = S.next(ui + 1, nxt);
        const char* nA = has_next ? (const char*)g.A + (size_t)nxt.pm * tstepA : cA; const char* nB = has_next ? (const char*)g.Bt + (size_t)nxt.pn * tstep : cB;
        for (int t = 0; t < nt; t += 2) {
            const bool last = (t == nt - 2);
            const char* a1 = cA + PG8_AOFF(t + 1);
            const char* a2 = last ? nA : cA + PG8_AOFF(t + 2); const char* b2 = last ? nB : cB + (size_t)(t + 2) * kstep;
            const char* a3 = a2 + kstep; const char* b3 = b2 + kstep;
            if (last && has_next) S.a_ready(nxt);
            if constexpr (SP2) {
            PG8_LDB(B0, 0, 0); PG8_LDB(B1, 0, 1); PG8_SCHED; PG8_LDA(At, 0, 0); PG8_STAGE(PG8_SA(1, 1), a1 + hstepA, voffA);
            PG8_WAIT_V(8); PG8_WAIT_L(0); PG8_BAR; PG8_MMA(0, 0, At, B0); PG8_MMA(0, 1, At, B1); PG8_BAR; PG8_SCHED;
            PG8_LDA(At, 0, 1); PG8_STAGE(PG8_SB(0, 0), b2, voffB); PG8_STAGE(PG8_SB(0, 1), b2 + hstepB, voffB); PG8_STAGE(PG8_SA(0, 0), a2, voffA);
            PG8_WAIT_V(8); PG8_WAIT_L(0); PG8_BAR; PG8_MMA(1, 0, At, B0); PG8_MMA(1, 1, At, B1); PG8_BAR; PG8_SCHED;
            PG8_LDB(B0, 1, 0); PG8_LDB(B1, 1, 1); PG8_SCHED; PG8_LDA(At, 1, 0); PG8_STAGE(PG8_SA(0, 1), a2 + hstepA, voffA);
            PG8_WAIT_V(8); PG8_WAIT_L(0); PG8_BAR; PG8_MMA(0, 0, At, B0); PG8_MMA(0, 1, At, B1); PG8_BAR; PG8_SCHED;
            PG8_LDA(At, 1, 1); PG8_STAGE(PG8_SB(1, 0), b3, voffB); PG8_STAGE(PG8_SB(1, 1), b3 + hstepB, voffB); PG8_STAGE(PG8_SA(1, 0), a3, voffA);
            PG8_WAIT_V(8); PG8_WAIT_L(0); PG8_BAR; PG8_MMA(1, 0, At, B0); PG8_MMA(1, 1, At, B1); PG8_BAR; PG8_SCHED;
            } else {
            PG8_LDB(B0, 0, 0); PG8_SCHED; PG8_LDA(At, 0, 0); PG8_STAGE(PG8_SA(1, 1), a1 + hstepA, voffA);
            PG8_WAIT_L(8); PG8_BAR; PG8_WAIT_L(0); PG8_MMA(0, 0, At, B0); PG8_BAR; PG8_SCHED;
            PG8_LDB(B1, 0, 1); PG8_STAGE(PG8_SB(0, 0), b2, voffB);
            PG8_BAR; PG8_WAIT_L(0); PG8_MMA(0, 1, At, B1); PG8_BAR;
            PG8_LDA(At, 0, 1); PG8_STAGE(PG8_SA(0, 0), a2, voffA);
            PG8_BAR; PG8_WAIT_L(0); PG8_MMA(1, 0, At, B0); PG8_BAR; PG8_SCHED;
            PG8_STAGE(PG8_SB(0, 1), b2 + hstepB, voffB);
            PG8_WAIT_V(6); PG8_BAR; PG8_MMA(1, 1, At, B1); PG8_BAR;
            PG8_LDB(B0, 1, 0); PG8_SCHED; PG8_LDA(At, 1, 0); PG8_STAGE(PG8_SA(0, 1), a2 + hstepA, voffA);
            PG8_WAIT_L(8); PG8_BAR; PG8_WAIT_L(0); PG8_MMA(0, 0, At, B0); PG8_BAR; PG8_SCHED;
            PG8_LDB(B1, 1, 1); PG8_STAGE(PG8_SB(1, 0), b3, voffB);
            PG8_BAR; PG8_WAIT_L(0); PG8_MMA(0, 1, At, B1); PG8_BAR;
            PG8_LDA(At, 1, 1); PG8_STAGE(PG8_SA(1, 0), a3, voffA);
            PG8_BAR; PG8_WAIT_L(0); PG8_MMA(1, 0, At, B0); PG8_BAR; PG8_SCHED;
            PG8_STAGE(PG8_SB(1, 1), b3 + hstepB, voffB);
            PG8_WAIT_V(6); PG8_BAR; PG8_MMA(1, 1, At, B1); PG8_BAR;
            }
        }
        if constexpr (ALIGN_EPI) { if (wr == 0) PG8_BAR; }
        if constexpr (!Epi::AFTER_DRAIN) { E(acc, cur, wr, wc, fr, fq); S.done(cur); }
        if (!has_next) break;
#pragma unroll
        for (int a = 0; a < 2; ++a)
#pragma unroll
            for (int b = 0; b < 2; ++b)
#pragma unroll
                for (int m = 0; m < 4; ++m)
#pragma unroll
                    for (int n = 0; n < 2; ++n) acc[a][b][m][n] = (f32x4){0.f, 0.f, 0.f, 0.f};
        cur = nxt; cA = nA; cB = nB; ++ui;
        if constexpr (ALIGN_EPI) { if (wr == 1) PG8_BAR; }
    }
    PG8_WAIT_V(0);
    if constexpr (!ALIGN_EPI) { if (wr == 0) PG8_BAR; }
    PG8_BAR;
#undef PG8_AOFF
#undef PG8_SA
#undef PG8_SB
#undef PG8_STAGE
#undef PG8_LDA
#undef PG8_LDB
#undef PG8_MMA
#undef PG8_WAIT_V
#undef PG8_WAIT_L
#undef PG8_BAR
#undef PG8_SCHED
}
}

#define XB_TMO      128
#define XB_XCNT(j)  (256  + 64 * (j))
#define XB_XSUB(j)  (1280 + 64 * (j))
#define XB_XGEN(j)  (2304 + 64 * (j))
#define XB_TOP      3328
#define XB_TOPGEN   3392
#define XCD_BAR_WORDS 3456
#define XB_SPIN_CAP (1u << 18)
__device__ __forceinline__ unsigned xb_ld(unsigned* p)              { return __hip_atomic_load(p, __ATOMIC_RELAXED, __HIP_MEMORY_SCOPE_AGENT); }
__device__ __forceinline__ unsigned xb_add(unsigned* p, unsigned v) { return __hip_atomic_fetch_add(p, v, __ATOMIC_RELAXED, __HIP_MEMORY_SCOPE_AGENT); }
__device__ __forceinline__ unsigned xb_xcc_id() { return (unsigned)__builtin_amdgcn_s_getreg((3 << 11) | 20) & 0xFu; }
#define XB_SPIN(cond, bar) do { unsigned _sp = 0; while (cond) { __builtin_amdgcn_s_sleep(1); \
    if ((++_sp & 255u) == 0u) { if (xb_ld(&(bar)[XB_TMO])) break; if (_sp > XB_SPIN_CAP) { atomicAdd(&(bar)[XB_TMO], 1u); break; } } } } while (0)
struct XcdBarrier { unsigned* bar; unsigned x; volatile LAS unsigned* st; };
__device__ __forceinline__ XcdBarrier xcd_barrier_post(unsigned* bar, volatile LAS unsigned* st) {
    XcdBarrier b; b.bar = bar; b.x = xb_xcc_id(); b.st = st;
    if (threadIdx.x == 0) (void)xb_add(&bar[XB_XCNT(b.x)], 1u);
    return b;
}
__device__ __forceinline__ void xcd_barrier_complete(unsigned* bar, unsigned x, unsigned& nloc, unsigned& nx) {
    const unsigned G = gridDim.x * gridDim.y * gridDim.z;
    unsigned sum, cnt, mine, sp = 0u;
    for (;;) {
        sum = 0u; cnt = 0u; mine = 0u;
#pragma unroll
        for (unsigned j = 0; j < 16; ++j) { const unsigned c = xb_ld(&bar[XB_XCNT(j)]); sum += c; cnt += (c > 0u) ? 1u : 0u; mine = (j == x) ? c : mine; }
        if (sum == G) break;
        __builtin_amdgcn_s_sleep(1);
        if ((++sp & 255u) == 0u) { if (xb_ld(&bar[XB_TMO])) break; if (sp > XB_SPIN_CAP) { atomicAdd(&bar[XB_TMO], 1u); break; } }
    }
    nloc = mine > 0u ? mine : 1u; nx = cnt > 0u ? cnt : 1u;
}
__device__ __forceinline__ void xcd_barrier(const XcdBarrier& b) {
    asm volatile("s_waitcnt vmcnt(0)" ::: "memory");
    __syncthreads();
    if (threadIdx.x == 0) {
        unsigned* bar = b.bar;
        __builtin_amdgcn_s_waitcnt(0);
        unsigned nloc = b.st[0], nx = b.st[1];
        if (nloc == 0u) { xcd_barrier_complete(bar, b.x, nloc, nx); b.st[0] = nloc; b.st[1] = nx; }
        const unsigned old = xb_add(&bar[XB_XSUB(b.x)], 1u);
        const unsigned gen = old / nloc;
        if (old + 1u == (gen + 1u) * nloc) {
            __builtin_amdgcn_fence(__ATOMIC_RELEASE, "agent");
            asm volatile("s_waitcnt vmcnt(0)" ::: "memory");
            const unsigned og = xb_add(&bar[XB_TOP], 1u);
            const unsigned tg = og / nx;
            if (og + 1u == (tg + 1u) * nx) xb_add(&bar[XB_TOPGEN], 1u);
            else XB_SPIN(xb_ld(&bar[XB_TOPGEN]) == tg, bar);
            __builtin_amdgcn_fence(__ATOMIC_ACQUIRE, "agent");
            xb_add(&bar[XB_XGEN(b.x)], 1u);
            asm volatile("s_waitcnt vmcnt(0)" ::: "memory");
        } else {
            XB_SPIN(xb_ld(&bar[XB_XGEN(b.x)]) == gen, bar);
            __builtin_amdgcn_fence(__ATOMIC_ACQUIRE, "agent");
            asm volatile("s_waitcnt vmcnt(0)" ::: "memory");
        }
    }
    __syncthreads();
}

namespace att {
#define SBAR() __builtin_amdgcn_sched_barrier(0)
constexpr float NEGS = -1e30f;
constexpr float M_INIT = -30000.f;
DI int crow(int r, int hi) { return (r & 3) + 8 * (r >> 2) + 4 * hi; }
template <int D> DI int koff(int row, int cb) { return row * (2 * D) + (cb ^ ((row & 7) << 4)); }
template <int D> DI int v_st(int k, int c) { const int kk = (k & ~0xC) | ((k & 4) << 1) | ((k & 8) >> 1); return ((kk >> 3) * (D / 32) + (c >> 5)) * 512 + ((kk & 7) * 32 + (c & 31)) * 2; }
DI int v_rd_base(int lane) { return ((lane & 3) << 3) | (((lane >> 2) & 3) << 6) | (((lane >> 4) & 1) << 5) | (((lane >> 5) & 1) << 8); }
template <int D> constexpr int v_rd_off(int d0, int ks, int half) { return d0 * 512 + ks * (2 * (D / 32) * 512) + half * ((D / 32) * 512); }
template <int OFF> DI s16x4 tr_read(int vb) { s16x4 r; asm volatile("ds_read_b64_tr_b16 %0, %1 offset:%2" : "=&v"(r) : "v"(vb), "i"(OFF) : "memory"); return r; }

template <int D> struct Core {
    float m_reg, l_reg; f32x16 o[D / 32]; bf16x8 qr[D / 16];
};
template <int D> DI void core_reset(Core<D>& c, float m0, float l0) {
    c.m_reg = m0; c.l_reg = l0;
#pragma unroll
    for (int d = 0; d < D / 32; ++d)
#pragma unroll
        for (int r = 0; r < 16; ++r) c.o[d][r] = 0.f;
}
template <int D> DI void load_q(Core<D>& c, const bf16_t* qrow, int hi) {
#pragma unroll
    for (int d0 = 0; d0 < D / 16; ++d0) c.qr[d0] = *(const GAS bf16x8*)(qrow + d0 * 16 + hi * 8);
}
template <int D, int NBT = 4> DI void qkt(f32x16& p0, f32x16& p1, const char* Ks, const bf16x8* qr, int r32, int hi) {
#pragma unroll
    for (int r = 0; r < 16; ++r) { p0[r] = 0.f; p1[r] = 0.f; }
    int rowb = r32 * (2 * D), swz = (r32 & 7) << 4; asm volatile("" : "+v"(rowb), "+v"(swz));
#pragma unroll
    for (int g4 = 0; g4 < D / (16 * NBT); ++g4) {
        bf16x8 kf[2 * NBT];
#pragma unroll
        for (int i = 0; i < NBT; ++i) { const int cb = ((g4 * NBT + i) * 16 + hi * 8) * 2;
            const char* kp = Ks + rowb + (cb ^ swz);
            kf[2 * i] = *reinterpret_cast<const bf16x8*>(kp);
            kf[2 * i + 1] = *reinterpret_cast<const bf16x8*>(kp + 64 * D); }
        SBAR();
#pragma unroll
        for (int i = 0; i < NBT; ++i) {
            p0 = __builtin_amdgcn_mfma_f32_32x32x16_bf16(kf[2 * i], qr[g4 * NBT + i], p0, 0, 0, 0);
            p1 = __builtin_amdgcn_mfma_f32_32x32x16_bf16(kf[2 * i + 1], qr[g4 * NBT + i], p1, 0, 0, 0); }
        SBAR();
    }
}
template <int D> DI void softmax_tile(f32x16& p0, f32x16& p1, float& m_reg, float& l_reg, float& alpha, bf16x8& pa0, bf16x8& pa1, bf16x8& pa2, bf16x8& pa3, bool rowok) {
    constexpr float SCALE = (D == 64) ? 0.125f : 0.088388347648318440f;
    constexpr float C = SCALE * 1.4426950408889634f, THRR = 8.f / SCALE;
    float pmax = p0[0];
#pragma unroll
    for (int r = 1; r < 16; ++r) pmax = fmaxf(pmax, p0[r]);
#pragma unroll
    for (int r = 0; r < 16; ++r) pmax = fmaxf(pmax, p1[r]);
    { auto rr = __builtin_amdgcn_permlane32_swap(__float_as_uint(pmax), __float_as_uint(pmax), false, false);
      pmax = fmaxf(__uint_as_float(rr[0]), __uint_as_float(rr[1])); }
    if (!rowok) pmax = NEGS;
    float mn;
    if (__builtin_expect(__all(pmax - m_reg <= THRR), 1)) { mn = m_reg; alpha = 1.f; }
    else { mn = fmaxf(m_reg, pmax); alpha = fast_exp2((m_reg - mn) * C); m_reg = mn; }
    const float mnC = rowok ? -mn * C : -__builtin_inff();
#pragma unroll
    for (int r = 0; r < 16; ++r) { p0[r] = fast_exp2(fmaf(p0[r], C, mnC)); p1[r] = fast_exp2(fmaf(p1[r], C, mnC)); }
    float ps = 0.f;
#pragma unroll
    for (int r = 0; r < 16; ++r) ps += p0[r];
#pragma unroll
    for (int r = 0; r < 16; ++r) ps += p1[r];
    { auto rr = __builtin_amdgcn_permlane32_swap(__float_as_uint(ps), __float_as_uint(ps), false, false);
      ps = __uint_as_float(rr[0]) + __uint_as_float(rr[1]); }
    l_reg = l_reg * alpha + ps;
#define PK4(P, BASE, OUT) do { unsigned a0 = cvtpk(P[BASE + 0], P[BASE + 1]), a1 = cvtpk(P[BASE + 2], P[BASE + 3]);   \
    unsigned b0 = cvtpk(P[BASE + 4], P[BASE + 5]), b1 = cvtpk(P[BASE + 6], P[BASE + 7]);                              \
    auto r0 = __builtin_amdgcn_permlane32_swap(a0, b0, false, false); auto r1 = __builtin_amdgcn_permlane32_swap(a1, b1, false, false); \
    u32x4 w = {r0[0], r1[0], r0[1], r1[1]}; OUT = *reinterpret_cast<bf16x8*>(&w); } while (0)
    PK4(p0, 0, pa0); PK4(p0, 8, pa1); PK4(p1, 0, pa2); PK4(p1, 8, pa3);
#undef PK4
}
template <int D, int D0> DI void pv_one(f32x16& od, int vb, bf16x8 pa0, bf16x8 pa1, bf16x8 pa2, bf16x8 pa3) {
    const s16x4 l0 = tr_read<v_rd_off<D>(D0, 0, 0)>(vb), h0 = tr_read<v_rd_off<D>(D0, 0, 1)>(vb), l1 = tr_read<v_rd_off<D>(D0, 1, 0)>(vb), h1 = tr_read<v_rd_off<D>(D0, 1, 1)>(vb);
    const s16x4 l2 = tr_read<v_rd_off<D>(D0, 2, 0)>(vb), h2 = tr_read<v_rd_off<D>(D0, 2, 1)>(vb), l3 = tr_read<v_rd_off<D>(D0, 3, 0)>(vb), h3 = tr_read<v_rd_off<D>(D0, 3, 1)>(vb);
    asm volatile("s_waitcnt lgkmcnt(0)" ::: "memory"); SBAR();
#define PK(L, H) (bf16x8){L[0], L[1], L[2], L[3], H[0], H[1], H[2], H[3]}
    od = __builtin_amdgcn_mfma_f32_32x32x16_bf16(pa0, PK(l0, h0), od, 0, 0, 0);
    od = __builtin_amdgcn_mfma_f32_32x32x16_bf16(pa1, PK(l1, h1), od, 0, 0, 0);
    od = __builtin_amdgcn_mfma_f32_32x32x16_bf16(pa2, PK(l2, h2), od, 0, 0, 0);
    od = __builtin_amdgcn_mfma_f32_32x32x16_bf16(pa3, PK(l3, h3), od, 0, 0, 0);
#undef PK
}
template <int D> DI void pv_all(f32x16* o, int vb, bf16x8 pa0, bf16x8 pa1, bf16x8 pa2, bf16x8 pa3) {
    pv_one<D, 0>(o[0], vb, pa0, pa1, pa2, pa3); pv_one<D, 1>(o[1], vb, pa0, pa1, pa2, pa3);
    if constexpr (D == 128) { pv_one<D, 2>(o[2], vb, pa0, pa1, pa2, pa3); pv_one<D, 3>(o[3], vb, pa0, pa1, pa2, pa3); }
}
template <int D> struct StgH { bf16x8 x[D / 64]; };
template <int D> DI void stg_ld(StgH<D>& s, const bf16_t* g, int pitch, int tid) {
    if constexpr (D == 128) { const int sr = tid >> 4, sc = (tid & 15) * 8;
        s.x[0] = *(const GAS bf16x8*)(g + (size_t)sr * pitch + sc); s.x[1] = *(const GAS bf16x8*)(g + (size_t)(sr + 32) * pitch + sc);
    } else { const int sr = tid >> 3, sc = (tid & 7) * 8; s.x[0] = *(const GAS bf16x8*)(g + (size_t)sr * pitch + sc); }
}
template <int D> DI void stg_wrK(const StgH<D>& s, char* Kl, int tid) {
    if constexpr (D == 128) { const int sr = tid >> 4, sc = (tid & 15) * 8; *(bf16x8*)(Kl + koff<D>(sr, sc * 2)) = s.x[0]; *(bf16x8*)(Kl + koff<D>(sr + 32, sc * 2)) = s.x[1]; }
    else { const int sr = tid >> 3, sc = (tid & 7) * 8; *(bf16x8*)(Kl + koff<D>(sr, sc * 2)) = s.x[0]; }
}
template <int D> DI void stg_wrV(const StgH<D>& s, char* Vl, int tid) {
    if constexpr (D == 128) { const int sr = tid >> 4, sc = (tid & 15) * 8; *(bf16x8*)(Vl + v_st<D>(sr, sc)) = s.x[0]; *(bf16x8*)(Vl + v_st<D>(sr + 32, sc)) = s.x[1]; }
    else { const int sr = tid >> 3, sc = (tid & 7) * 8; *(bf16x8*)(Vl + v_st<D>(sr, sc)) = s.x[0]; }
}
#define LBAR() asm volatile("s_waitcnt lgkmcnt(0)\n\ts_barrier" ::: "memory")
template <int D, class MaskF>
DI void tile_finish(Core<D>& c, f32x16& p0, f32x16& p1, int j, const MaskF& mk, float* ws, int vb, int r32, int hi) {
    if (mk.partial(j)) { const int kb = 64 * j;
#pragma unroll
        for (int r = 0; r < 16; ++r) { const int k0 = kb + crow(r, hi); if (!mk.ok(j, k0)) p0[r] = NEGS; if (!mk.ok(j, k0 + 32)) p1[r] = NEGS; } }
    float alpha; bf16x8 pa0, pa1, pa2, pa3;
    softmax_tile<D>(p0, p1, c.m_reg, c.l_reg, alpha, pa0, pa1, pa2, pa3, mk.rowok(j));
    if (__any(alpha < 1.f)) { if (hi == 0) ws[32 + r32] = alpha; LDS_WAIT();
#pragma unroll
        for (int r = 0; r < 16; ++r) { const float a = ws[32 + crow(r, hi)];
#pragma unroll
            for (int d = 0; d < D / 32; ++d) c.o[d][r] *= a; } }
    SBAR();
    pv_all<D>(c.o, vb, pa0, pa1, pa2, pa3);
}
template <int D, bool PIPE, class Seq, class MaskF, class KX>
DI void run_tiles(Core<D>& c, char* kv, float* ws, const bf16_t* Kg0, const bf16_t* Vg0, int pitch, const Seq& seq, const MaskF& mk, const KX& kx, int tid_, int lane_) {
    constexpr int KB = 64 * D * 2;
    int tid = tid_, lane = lane_; asm volatile("" : "+v"(tid), "+v"(lane));
    const int r32 = lane & 31, hi = lane >> 5;
    int t0; if (!seq.first(t0)) return;
    const int vb0 = (int)(uintptr_t)(kv + 2 * KB) + v_rd_base(lane);
    StgH<D> sk, sv;
    if constexpr (!PIPE) {
        stg_ld<D>(sk, Kg0 + (size_t)64 * t0 * pitch, pitch, tid); stg_ld<D>(sv, Vg0 + (size_t)64 * t0 * pitch, pitch, tid);
        LBAR();
        kx.apply(sk, t0, tid); stg_wrK<D>(sk, kv, tid); stg_wrV<D>(sv, kv + 2 * KB, tid);
        LBAR();
        int buf = 0;
        for (;;) {
            int t1 = 0; const bool e1 = seq.next(t0, t1);
            if (e1) { stg_ld<D>(sk, Kg0 + (size_t)64 * t1 * pitch, pitch, tid); stg_ld<D>(sv, Vg0 + (size_t)64 * t1 * pitch, pitch, tid); }
            f32x16 p0, p1; qkt<D>(p0, p1, kv + buf * KB, c.qr, r32, hi);
            tile_finish<D>(c, p0, p1, t0, mk, ws, vb0 + buf * KB, r32, hi);
            if (e1) { kx.apply(sk, t1, tid); stg_wrK<D>(sk, kv + (buf ^ 1) * KB, tid); stg_wrV<D>(sv, kv + 2 * KB + (buf ^ 1) * KB, tid); }
            LBAR();
            if (!e1) break;
            t0 = t1; buf ^= 1;
        }
    } else {
    int t1 = 0, t2 = 0, t3 = 0;
    bool e1 = seq.next(t0, t1), e2 = e1 && seq.next(t1, t2), e3 = e2 && seq.next(t2, t3);
    stg_ld<D>(sk, Kg0 + (size_t)64 * t0 * pitch, pitch, tid); stg_ld<D>(sv, Vg0 + (size_t)64 * t0 * pitch, pitch, tid);
    LBAR();
    kx.apply(sk, t0, tid); stg_wrK<D>(sk, kv, tid); stg_wrV<D>(sv, kv + 2 * KB, tid);
    if (e1) { stg_ld<D>(sk, Kg0 + (size_t)64 * t1 * pitch, pitch, tid); kx.apply(sk, t1, tid); stg_wrK<D>(sk, kv + KB, tid); }
    LBAR();
    f32x16 pA0, pA1, pB0, pB1;
    qkt<D>(pA0, pA1, kv, c.qr, r32, hi);
    if (e2) stg_ld<D>(sk, Kg0 + (size_t)64 * t2 * pitch, pitch, tid);
    if (e1) stg_ld<D>(sv, Vg0 + (size_t)64 * t1 * pitch, pitch, tid);
    LBAR();
#define ATT_STEP(P0, P1, Q0, Q1, PAR) do { \
        if (e2) { kx.apply(sk, t2, tid); stg_wrK<D>(sk, kv + (PAR) * KB, tid); } \
        if (e1) stg_wrV<D>(sv, kv + 2 * KB + ((PAR) ^ 1) * KB, tid); \
        if (e3) stg_ld<D>(sk, Kg0 + (size_t)64 * t3 * pitch, pitch, tid); \
        if (e2) stg_ld<D>(sv, Vg0 + (size_t)64 * t2 * pitch, pitch, tid); \
        if (e1) qkt<D>(Q0, Q1, kv + ((PAR) ^ 1) * KB, c.qr, r32, hi); \
        tile_finish<D>(c, P0, P1, t0, mk, ws, vb0 + (PAR) * KB, r32, hi); \
        LBAR(); \
    } while (0)
    for (;;) {
        ATT_STEP(pA0, pA1, pB0, pB1, 0);
        if (!e1) break;
        t0 = t1; t1 = t2; t2 = t3; e1 = e2; e2 = e3; e3 = e2 && seq.next(t2, t3);
        ATT_STEP(pB0, pB1, pA0, pA1, 1);
        if (!e1) break;
        t0 = t1; t1 = t2; t2 = t3; e1 = e2; e2 = e3; e3 = e2 && seq.next(t2, t3);
    }
#undef ATT_STEP
    }
}
#undef SBAR
}

struct Args { const float* in[24]; float* out; unsigned char* ws; };
template <int OFF> DI unsigned long long karg_u64() {
    unsigned long long v; auto kp = __builtin_amdgcn_kernarg_segment_ptr();
    asm volatile("s_load_dwordx2 %0, %1, %2\n\ts_waitcnt lgkmcnt(0)" : "=s"(v) : "s"(kp), "n"(OFF));
    return v;
}
template <int I> DI const float* arg_in() { return (const float*)karg_u64<8 * I>(); }
DI float* arg_out() { return (float*)karg_u64<192>(); }
DI unsigned char* arg_ws() { return (unsigned char*)karg_u64<200>(); }

DI float wave_sum(float v) {
#pragma unroll
    for (int o = 1; o < 64; o <<= 1) v += __shfl_xor(v, o);
    return v;
}
struct TJob { const float* src; const float* gain; bf16_t* dst; int K, pitch, nsrc, ndst, mode, coff; };
DI void get_job(int j, TJob& J) {
    unsigned char* ws = arg_ws(); J.gain = nullptr; J.mode = 0; J.coff = 0;
    if (j < 16) { const int L = j >> 2, k = j & 3, w = k >> 1;
        if ((k & 1) == 0) { J.src = (w ? arg_in<7>() : arg_in<3>()) + (size_t)L * DM * NFF; J.gain = (w ? arg_in<6>() : arg_in<2>()) + (size_t)L * DM; J.dst = (bf16_t*)(ws + WS_WFI + (size_t)(L * 2 + w) * SZ_WFI);
            J.K = DM; J.pitch = NFF; J.nsrc = NFF; J.ndst = NFF; J.mode = 1; }
        else { J.src = (w ? arg_in<8>() : arg_in<4>()) + (size_t)L * DFF * DM; J.dst = (bf16_t*)(ws + WS_WFO + (size_t)(L * 2 + w) * SZ_WFO); J.K = DFF; J.pitch = DM; J.nsrc = DM; J.ndst = DM; }
    } else if (j < 24) { const int jj = j - 16, L2 = jj >> 2, k = jj & 3;
        if (k == 0) { J.src = arg_in<9>() + (size_t)L2 * DM * SW_N; J.gain = arg_in<5>() + (size_t)(2 * L2) * DM; J.dst = (bf16_t*)(ws + WS_WSI + (size_t)L2 * SZ_WSI); J.K = DM; J.pitch = SW_N; J.nsrc = SW_N; J.ndst = SW_N; }
        else if (k == 1) { J.src = arg_in<13>() + (size_t)L2 * DM * DM; J.dst = (bf16_t*)(ws + WS_WSO + (size_t)L2 * SZ_WO); J.K = DM; J.pitch = DM; J.nsrc = DM; J.ndst = DM; }
        else if (k == 2) { J.src = arg_in<14>() + (size_t)L2 * DM * NS_NREAL; J.gain = arg_in<5>() + (size_t)(2 * L2 + 1) * DM; J.dst = (bf16_t*)(ws + WS_WNI + (size_t)L2 * SZ_WNI); J.K = DM; J.pitch = NS_NREAL; J.nsrc = NS_N; J.ndst = NS_N; }
        else { J.src = arg_in<23>() + (size_t)L2 * DM * DM; J.dst = (bf16_t*)(ws + WS_WNO + (size_t)L2 * SZ_WO); J.K = DM; J.pitch = DM; J.nsrc = DM; J.ndst = DM; }
    } else if (j >= 32) { const int L2 = j - 32;
        J.src = arg_in<14>() + (size_t)L2 * DM * NS_NREAL; J.gain = arg_in<5>() + (size_t)(2 * L2 + 1) * DM; J.dst = (bf16_t*)(ws + WS_WG + (size_t)L2 * SZ_WG); J.K = DM; J.pitch = NS_NREAL; J.nsrc = 48; J.ndst = 64; J.coff = NS_N;
    } else { const int jj = j - 24, L2 = jj >> 2, k = jj & 3;
        if (k < 2) { J.src = (k == 0 ? arg_in<18>() : arg_in<21>()) + (size_t)L2 * 4096 * 256; J.dst = (bf16_t*)(ws + WS_W1 + (size_t)(L2 * 2 + k) * SZ_W1); J.K = 4096; J.pitch = 256; J.nsrc = 256; J.ndst = 256; J.mode = 2; }
        else { J.src = (k == 2 ? arg_in<19>() : arg_in<22>()) + (size_t)L2 * 256 * 128; J.dst = (bf16_t*)(ws + WS_W2 + (size_t)(L2 * 2 + (k - 2)) * SZ_W2); J.K = 256; J.pitch = 128; J.nsrc = 128; J.ndst = 128; }
    }
}
DI void transpose_item(const TJob& J, LAS float* scr, int item, int lane) {
    const int nblk = J.ndst / 64, kb = item / nblk, nb = item % nblk, k0 = 64 * kb, n0 = 64 * nb;
    int sc0 = n0; if (J.mode == 1) sc0 = ((n0 & 255) >> 7) * DFF + (n0 >> 8) * 128 + (n0 & 127);
    const int ln = lane & 15, kr = lane >> 4;
    const int col = J.coff + sc0 + 4 * ln; const bool okc = (n0 + 4 * ln) < J.nsrc;
    f32x4 v[16];
#pragma unroll
    for (int i = 0; i < 16; ++i) v[i] = okc ? __builtin_nontemporal_load((const GAS f32x4*)(J.src + (size_t)(k0 + 4 * i + kr) * J.pitch + col)) : (f32x4){0.f, 0.f, 0.f, 0.f};
#pragma unroll
    for (int i = 0; i < 16; ++i) { LAS float* d = scr + (4 * i + kr) * 65 + 4 * ln; d[0] = v[i][0]; d[1] = v[i][1]; d[2] = v[i][2]; d[3] = v[i][3]; }
    const int c = lane & 7;
    f32x4 ga = {1.f, 1.f, 1.f, 1.f}, gb = {1.f, 1.f, 1.f, 1.f};
    if (J.gain) { ga = *(const GAS f32x4*)(J.gain + k0 + 8 * c); gb = *(const GAS f32x4*)(J.gain + k0 + 8 * c + 4); }
    LDS_WAIT(); asm volatile("" ::: "memory");
#pragma unroll
    for (int jx = 0; jx < 8; ++jx) { const int n = (lane >> 3) + 8 * jx; const LAS float* s = scr + (8 * c) * 65 + n;
        u32x4 o; o.x = cvtpk(s[0 * 65] * ga[0], s[1 * 65] * ga[1]); o.y = cvtpk(s[2 * 65] * ga[2], s[3 * 65] * ga[3]); o.z = cvtpk(s[4 * 65] * gb[0], s[5 * 65] * gb[1]); o.w = cvtpk(s[6 * 65] * gb[2], s[7 * 65] * gb[3]);
        const int nn = n0 + n, k8 = (k0 >> 3) + c;
        const size_t di = J.mode == 2 ? ((size_t)((nn >> 5) * (J.K >> 4) + (k8 >> 1)) * 64 + (nn & 31) + 32 * (k8 & 1)) * 8
                                       : (size_t)nn * J.K + k0 + 8 * c;
        *(GAS u32x4*)(J.dst + di) = o; }
    LDS_WAIT(); asm volatile("" ::: "memory");
}
constexpr int NJOBS_PRO = 30;
__device__ const unsigned char JOB_ORDER[NJOBS_PRO] = {12,13,14,15,22,23,28,29,30,31,33,8,9,10,20,4,5,6,7,18,19,24,25,26,27,32,16,2,1,0};
DI void prologue(LAS unsigned char* lds, int vcu, int G, int wave, int lane) {
    unsigned char* const wsb = arg_ws();
    LAS float* scr = (LAS float*)(lds + wave * 16640);
    const int gw = vcu * NWAVES + wave, NGW = G * NWAVES;
    {
        const int* pos = (const int*)arg_in<1>();
        float* t64 = (float*)(wsb + WS_ROPE64); float* t128 = (float*)(wsb + WS_ROPE128);
        const int i = lane < 8 ? lane : lane - 8;
        const double ex = lane < 8 ? (double)i / 8.0 : (double)i / 16.0;
        const float inv = (float)(1.0 / exp2(ex * 18.931568569324174));
        for (int m = gw; m < M; m += NGW) {
            if (lane < 24) {
                const float ang = (float)((const GAS int*)pos)[m] * inv;
                double rev = (double)ang * 0.15915494309189535; rev -= floor(rev);
                const float fr = (float)rev;
                const float sn = __builtin_amdgcn_sinf(fr), cs = __builtin_amdgcn_cosf(fr);
                if (lane < 8) { ((GAS float*)t64)[(size_t)m * 16 + i] = cs; ((GAS float*)t64)[(size_t)m * 16 + 8 + i] = sn; }
                else { ((GAS float*)t128)[(size_t)m * 32 + i] = cs; ((GAS float*)t128)[(size_t)m * 32 + 16 + i] = sn; }
            }
        }
    }
    {
        const float* x = arg_in<0>(); bf16_t* hb = (bf16_t*)(wsb + WS_HB); bf16_t* lb = (bf16_t*)(wsb + WS_LB); float* rowss = (float*)(wsb + WS_ROWSS);
        for (int m = gw; m < M; m += NGW) {
            const GAS f32x4* xr = (const GAS f32x4*)(x + (size_t)m * DM) + lane; float s = 0.f;
            GAS u32x2* l8 = (GAS u32x2*)(lb + (size_t)m * DM) + lane;
#pragma unroll
            for (int jx = 0; jx < 8; ++jx) { const f32x4 v = xr[64 * jx]; s += (v[0] * v[0] + v[1] * v[1]) + (v[2] * v[2] + v[3] * v[3]);
                u32x2 w; w.x = cvtpk(v[0], v[1]); w.y = cvtpk(v[2], v[3]);
                { const int c = (jx * 64 + lane) * 4; *(GAS u32x2*)(hb + (size_t)(c >> 8) * ((size_t)M * 256) + (size_t)m * 256 + (c & 255)) = w; }
                if (RES_LO) { u32x2 wl; wl.x = cvtpk(v[0] - bflo(w.x), v[1] - bfhi(w.x)); wl.y = cvtpk(v[2] - bflo(w.y), v[3] - bfhi(w.y)); l8[64 * jx] = wl; } }
            s = wave_sum(s);
            if (lane < 32) ((GAS float*)rowss)[(size_t)lane * M + m] = lane == 0 ? s : 0.f;
        }
    }
    {
        for (int tk = gw; tk < 128; tk += NGW) { const int L2 = tk >> 6, kvi = (tk >> 5) & 1, l = tk & 31;
            const float* pe = (kvi ? arg_in<20>() : arg_in<17>()) + (size_t)L2 * 32 * 128 + l * 128;
            const float* w1 = (kvi ? arg_in<21>() : arg_in<18>()) + (size_t)L2 * 4096 * 256 + (size_t)l * 128 * 256;
            f32x4 acc = {0.f, 0.f, 0.f, 0.f};
            for (int d = 0; d < 128; ++d) { const float p = ((const GAS float*)pe)[d]; const f32x4 w = ((const GAS f32x4*)(w1 + (size_t)d * 256))[lane]; acc += w * p; }
            ((GAS f32x4*)(wsb + WS_BIASP + (size_t)(L2 * 2 + kvi) * SZ_BIASP + (size_t)l * 256 * 4))[lane] = acc;
        }
    }
    int off = gw;
    for (int jo = 0; jo < NJOBS_PRO; ++jo) {
        const int j = (int)JOB_ORDER[jo];
        TJob J; get_job(j, J);
        const int nitems = (J.K / 64) * (J.ndst / 64);
        int it = off;
        for (; it < nitems; it += NGW) transpose_item(J, scr, it, lane);
        off = it - nitems;
    }
}

DI void convert_deferred(LAS unsigned char* lds, int L2, int idx, int NIDLE, int wave, int lane) {
    LAS float* scr = (LAS float*)(lds + wave * 16640);
    const int gw = idx * NWAVES + wave, NGW = NIDLE * NWAVES;
    int off = gw;
#pragma unroll 1
    for (int q = 0; q < 2; ++q) {
        const int j = q == 0 ? 17 + 4 * L2 : 3 + 8 * L2;
        TJob J; get_job(j, J);
        const int nitems = (J.K / 64) * (J.ndst / 64);
        int it = off;
        for (; it < nitems; it += NGW) transpose_item(J, scr, it, lane);
        off = it - nitems;
    }
}

template <int CTRL> DI float dppf(float v) { return __builtin_bit_cast(float, __builtin_amdgcn_update_dpp(0, __builtin_bit_cast(int, v), CTRL, 0xF, 0xF, false)); }
template <int LPR> DI float row_sum(float ss) {
    ss += dppf<0xB1>(ss); ss += dppf<0x4E>(ss); ss += dppf<0x141>(ss);
    if constexpr (LPR == 16) ss += dppf<0x140>(ss);
    return ss;
}
template <int HD> DI void norm_rope8(float (&x)[8], const float* gain, const float* tab  , int sub) {
    constexpr int LPR = HD / 8, HALFR = HD / 8;
    float ss = 0.f;
#pragma unroll
    for (int e = 0; e < 8; ++e) ss += x[e] * x[e];
    if constexpr (HD == 64) ss = row_sum<LPR>(ss); else {
#pragma unroll
    for (int o = 1; o < LPR; o <<= 1) ss += __shfl_xor(ss, o); }
    const float rs = rsqrtf(ss * (1.0f / HD) + EPS);
#pragma unroll
    for (int e = 0; e < 8; ++e) x[e] = x[e] * rs * ((const GAS float*)gain)[sub * 8 + e];
    constexpr int XL = HALFR / 8;
    float y[8];
#pragma unroll
    for (int e = 0; e < 8; ++e) { if constexpr (HD == 64) y[e] = dppf<XL == 1 ? 0xB1 : 0x4E>(x[e]); else y[e] = __shfl_xor(x[e], XL); }
    if (sub < 2 * XL) {
        const bool first = sub < XL; const int i0 = (sub & (XL - 1)) * 8;
#pragma unroll
        for (int e = 0; e < 8; ++e) { const float cs = ((const GAS float*)tab)[i0 + e], sn = ((const GAS float*)tab)[HALFR + i0 + e];
            x[e] = first ? (x[e] * cs - y[e] * sn) : (x[e] * cs + y[e] * sn); }
    }
}
template <int D> DI void qnorm_rope(att::Core<D>& c, const float* gain, const float* tab, int hi) {
    constexpr int ND = D / 16, HALFR = D / 8;
    float x[ND][8]; float ss = 0.f;
#pragma unroll
    for (int d0 = 0; d0 < ND; ++d0) { const u32x4 w = __builtin_bit_cast(u32x4, c.qr[d0]);
        x[d0][0] = bflo(w.x); x[d0][1] = bfhi(w.x); x[d0][2] = bflo(w.y); x[d0][3] = bfhi(w.y); x[d0][4] = bflo(w.z); x[d0][5] = bfhi(w.z); x[d0][6] = bflo(w.w); x[d0][7] = bfhi(w.w);
#pragma unroll
        for (int e = 0; e < 8; ++e) ss += x[d0][e] * x[d0][e]; }
    ss = sum_xor32(ss);
    const float rs = __builtin_amdgcn_rsqf(ss * (1.0f / D) + EPS);
#pragma unroll
    for (int d0 = 0; d0 < ND; ++d0) { const f32x4 ga = *(const GAS f32x4*)(gain + d0 * 16 + hi * 8), gb = *(const GAS f32x4*)(gain + d0 * 16 + hi * 8 + 4);
#pragma unroll
        for (int e = 0; e < 8; ++e) x[d0][e] = x[d0][e] * rs * (e < 4 ? ga[e] : gb[e - 4]); }
    if constexpr (D == 64) {
        const f32x4 ca = *(const GAS f32x4*)(tab), cb = *(const GAS f32x4*)(tab + 4), sa = *(const GAS f32x4*)(tab + HALFR), sb = *(const GAS f32x4*)(tab + HALFR + 4);
#pragma unroll
        for (int e = 0; e < 8; ++e) { const float cs = e < 4 ? ca[e] : cb[e - 4], sn = e < 4 ? sa[e] : sb[e - 4];
            auto rr = __builtin_amdgcn_permlane32_swap(__float_as_uint(x[0][e]), __float_as_uint(x[0][e]), false, false);
            const float y = __uint_as_float(hi ? rr[0] : rr[1]);
            x[0][e] = hi ? (x[0][e] * cs + y * sn) : (x[0][e] * cs - y * sn); }
    } else {
        const f32x4 ca = *(const GAS f32x4*)(tab + hi * 8), cb = *(const GAS f32x4*)(tab + hi * 8 + 4), sa = *(const GAS f32x4*)(tab + HALFR + hi * 8), sb = *(const GAS f32x4*)(tab + HALFR + hi * 8 + 4);
#pragma unroll
        for (int e = 0; e < 8; ++e) { const float cs = e < 4 ? ca[e] : cb[e - 4], sn = e < 4 ? sa[e] : sb[e - 4];
            const float x1 = x[0][e], x2 = x[1][e]; x[0][e] = x1 * cs - x2 * sn; x[1][e] = x2 * cs + x1 * sn; }
    }
#pragma unroll
    for (int d0 = 0; d0 < ND; ++d0) { u32x4 w; w.x = cvtpk(x[d0][0], x[d0][1]); w.y = cvtpk(x[d0][2], x[d0][3]); w.z = cvtpk(x[d0][4], x[d0][5]); w.w = cvtpk(x[d0][6], x[d0][7]); c.qr[d0] = __builtin_bit_cast(bf16x8, w); }
}
struct KxNone { DI void apply(att::StgH<64>&, int, int) const {} DI void apply(att::StgH<128>&, int, int) const {} };
struct KxNorm64 { const float* gain; const float* tab;
    DI void apply(att::StgH<64>& s, int tile, int tid) const {
        const int sr = tid >> 3, sub = tid & 7; const u32x4 w = __builtin_bit_cast(u32x4, s.x[0]); float x[8];
        x[0] = bflo(w.x); x[1] = bfhi(w.x); x[2] = bflo(w.y); x[3] = bfhi(w.y); x[4] = bflo(w.z); x[5] = bfhi(w.z); x[6] = bflo(w.w); x[7] = bfhi(w.w);
        norm_rope8<64>(x, gain, tab + (size_t)(64 * tile + sr) * 16, sub);
        u32x4 o; o.x = cvtpk(x[0], x[1]); o.y = cvtpk(x[2], x[3]); o.z = cvtpk(x[4], x[5]); o.w = cvtpk(x[6], x[7]); s.x[0] = __builtin_bit_cast(bf16x8, o); }
    DI void apply(att::StgH<128>&, int, int) const {} };
DI void ld8(const bf16_t* p, float (&x)[8]) { const u32x4 w = *(const GAS u32x4*)p; x[0] = bflo(w.x); x[1] = bfhi(w.x); x[2] = bflo(w.y); x[3] = bfhi(w.y); x[4] = bflo(w.z); x[5] = bfhi(w.z); x[6] = bflo(w.w); x[7] = bfhi(w.w); }
DI void st8(bf16_t* p, const float (&x)[8]) { u32x4 w; w.x = cvtpk(x[0], x[1]); w.y = cvtpk(x[2], x[3]); w.z = cvtpk(x[4], x[5]); w.w = cvtpk(x[6], x[7]); *(GAS u32x4*)p = w; }

DI void nsa_normrope(int L2, int gw, int NGW, int lane) {
    unsigned char* const wsb = arg_ws();
    bf16_t* qkv = (bf16_t*)(wsb + WS_ACT); const float* tab = (const float*)(wsb + WS_ROPE128);
    const float* kg = arg_in<16>() + L2 * 128;
    const int grp = lane >> 4, sub = lane & 15;
    float gn[8];
#pragma unroll
    for (int e = 0; e < 8; ++e) gn[e] = ((const GAS float*)kg)[sub * 8 + e];
    const bool roper = sub < 4, first = sub < 2; const int i0 = (sub & 1) * 8;
    const long nrows = (long)M * 8, stride = (long)NGW * 4;
    for (long hr0 = (long)gw * 4 + grp; hr0 < nrows; hr0 += stride * 4) {
        u32x4 w[4]; f32x4 ca[4], cb[4], sa[4], sb[4]; bf16_t* p[4]; bool ok[4];
#pragma unroll
        for (int u = 0; u < 4; ++u) { const long hr = hr0 + u * stride; ok[u] = hr < nrows; const long hq = ok[u] ? hr : hr0;
            const int m = (int)(hq >> 3), j = (int)(hq & 7); const int col = j < 4 ? NS_KS + j * 128 : NS_KW + (j - 4) * 128;
            p[u] = qkv + (size_t)m * NS_N + col + sub * 8; w[u] = *(const GAS u32x4*)p[u];
            const float* t = tab + (size_t)m * 32 + i0;
            ca[u] = *(const GAS f32x4*)t; cb[u] = *(const GAS f32x4*)(t + 4); sa[u] = *(const GAS f32x4*)(t + 16); sb[u] = *(const GAS f32x4*)(t + 20); }
#pragma unroll
        for (int u = 0; u < 4; ++u) {
            float x[8]; x[0] = bflo(w[u].x); x[1] = bfhi(w[u].x); x[2] = bflo(w[u].y); x[3] = bfhi(w[u].y); x[4] = bflo(w[u].z); x[5] = bfhi(w[u].z); x[6] = bflo(w[u].w); x[7] = bfhi(w[u].w);
            float ss = 0.f;
#pragma unroll
            for (int e = 0; e < 8; ++e) ss += x[e] * x[e];
            ss = row_sum<16>(ss);
            const float rs = rsqrtf(ss * (1.0f / 128) + EPS);
#pragma unroll
            for (int e = 0; e < 8; ++e) x[e] = x[e] * rs * gn[e];
            float y[8];
#pragma unroll
            for (int e = 0; e < 8; ++e) y[e] = dppf<0x4E>(x[e]);
            if (roper) {
#pragma unroll
                for (int e = 0; e < 8; ++e) { const float cs = e < 4 ? ca[u][e] : cb[u][e - 4], sn = e < 4 ? sa[u][e] : sb[u][e - 4];
                    x[e] = first ? (x[e] * cs - y[e] * sn) : (x[e] * cs + y[e] * sn); }
            }
            if (ok[u]) st8(p[u], x);
        }
    }
}

struct SeqRange { int lo, hi; DI bool first(int& j) const { j = lo; return lo <= hi; } DI bool next(int j, int& jn) const { jn = j + 1; return jn <= hi; } };
struct MaskWin { int t, w, tmin, tmax;
    DI bool ok(int, int key) const { return key <= t && key > t - w; }
    DI bool partial(int j) const { return !(64 * j + 63 <= tmin && 64 * j > tmax - w); }
    DI bool rowok(int) const { return true; } };
DI void swa_attention(int L2, char* lds, int vcu, int G, int tid, int wave, int lane) {
#define SWA_QKV ((const bf16_t*)(arg_ws() + WS_ACT))
#define SWA_RTAB ((const float*)(arg_ws() + WS_ROPE64))
    const int r32 = lane & 31, hi = lane >> 5;
    constexpr int KB = 8192;
    char* const Kl = lds; char* const Vl = lds + 32768;
    float* ws = (float*)(lds + 65536) + wave * 64;
    bf16_t* stg = (bf16_t*)(lds + 65536 + 2048) + wave * 2048;
    constexpr int NU = NB * 4 * (T / 64);
    const int per = (NU + G - 1) / G;
    for (int ui = 0; ui < per; ++ui) {
        const int u = vcu * per + ui; if (u >= NU) break;
        const int bg = u / (T / 64), q64 = u % (T / 64), b = bg >> 2, g = bg & 3;
        const int t0 = q64 * 64, h = 8 * g + wave, jlo = q64 - 2 < 0 ? 0 : q64 - 2, ntl = q64 - jlo + 1;
        att::Core<64> c;
        {
            att::StgH<64> sk[3], sv[3];
            const bf16_t* Kg = SWA_QKV + (size_t)b * T * SW_N + 2048 + g * 64; const bf16_t* Vg = Kg + 256;
#pragma unroll
            for (int sl = 0; sl < 3; ++sl) if (sl < ntl) { att::stg_ld<64>(sk[sl], Kg + (size_t)64 * (jlo + sl) * SW_N, SW_N, tid); att::stg_ld<64>(sv[sl], Vg + (size_t)64 * (jlo + sl) * SW_N, SW_N, tid); }
            att::load_q<64>(c, SWA_QKV + (size_t)(b * T + t0 + r32) * SW_N + h * 64, hi);
            KxNorm64 kx; kx.gain = arg_in<11>() + L2 * 64; kx.tab = SWA_RTAB + (size_t)b * T * 16;
#pragma unroll
            for (int sl = 0; sl < 3; ++sl) if (sl < ntl) { kx.apply(sk[sl], jlo + sl, tid); att::stg_wrK<64>(sk[sl], Kl + sl * KB, tid); att::stg_wrV<64>(sv[sl], Vl + sl * KB, tid); }
        }
        __syncthreads();
        const int vb0 = (int)(uintptr_t)Vl + att::v_rd_base(lane);
        const float sink = ((const GAS float*)(arg_in<12>() + L2 * 32))[h];
#pragma unroll 1
        for (int hb = 0; hb < 2; ++hb) {
            const int tq0 = t0 + 32 * hb, t = tq0 + r32;
            if (hb) att::load_q<64>(c, SWA_QKV + (size_t)(b * T + t) * SW_N + h * 64, hi);
            qnorm_rope<64>(c, arg_in<10>() + L2 * 64, SWA_RTAB + (size_t)(b * T + t) * 16, hi);
            att::core_reset<64>(c, sink * 8.0f, 1.0f);
            MaskWin mk; mk.t = t; mk.w = 128; mk.tmin = tq0; mk.tmax = tq0 + 31;
#pragma unroll 1
            for (int sl = 0; sl < ntl; ++sl) {
                f32x16 p0, p1; att::qkt<64>(p0, p1, Kl + sl * KB, c.qr, r32, hi);
                att::tile_finish<64>(c, p0, p1, jlo + sl, mk, ws, vb0 + sl * KB, r32, hi);
            }
            if (hi == 0) ws[r32] = fast_rcp(c.l_reg);
            LDS_WAIT();
#pragma unroll
            for (int r = 0; r < 16; ++r) { const int orow = att::crow(r, hi); const float f = ws[orow];
#pragma unroll
                for (int d0 = 0; d0 < 2; ++d0) stg[orow * 64 + d0 * 32 + r32] = f2bf1(c.o[d0][r] * f); }
            LDS_WAIT();
#pragma unroll
            for (int i = 0; i < 4; ++i) { const int row = i * 8 + (lane >> 3), ch = lane & 7; const u32x4 v = *(const u32x4*)(stg + row * 64 + ch * 8);
                *(GAS u32x4*)((bf16_t*)(arg_ws() + WS_OB) + (size_t)(b * T + tq0 + row) * DM + h * 64 + ch * 8) = v; }
            LDS_WAIT();
        }
        __syncthreads();
    }
}

DI void nsa_compress(int L2, char* lds, int vcu, int G, int tid, int wave, int lane) {
    unsigned char* const wsb = arg_ws(); const float* const kgain = arg_in<16>() + L2 * 128;
    const bf16_t* qkv = (const bf16_t*)(wsb + WS_ACT);
    const int r32 = lane & 31, hi = lane >> 5;
    char* abuf = lds; bf16_t* hid = (bf16_t*)(lds + 65536); float* outf = (float*)(lds + 65536 + 17408);
    const int sn = tid >> 4, sc16 = tid & 15;
    for (int it = vcu; it < 256; it += G) {
        const int kvi = it >> 7, bg = (it >> 3) & 15, nt = it & 7, b = bg >> 2, g = bg & 3, n0 = nt * 32;
        const bf16_t* w1t = (const bf16_t*)(wsb + WS_W1 + (size_t)(L2 * 2 + kvi) * SZ_W1);
        const bf16_t* w2t = (const bf16_t*)(wsb + WS_W2 + (size_t)(L2 * 2 + kvi) * SZ_W2);
        const float* biasp = (const float*)(wsb + WS_BIASP + (size_t)(L2 * 2 + kvi) * SZ_BIASP);
        const int colb = (kvi ? NS_VC : NS_KC) + g * 128;
        f32x16 acc;
#pragma unroll
        for (int r = 0; r < 16; ++r) acc[r] = 0.f;
        const bf16_t* brow = w1t + ((size_t)wave * 256 * 64 + lane) * 8;
        bf16x8 areg[8];
#define CMP_ALOAD(ck) do { _Pragma("unroll") for (int i_ = 0; i_ < 8; ++i_) { int tok_ = 16 * (n0 + sn) + 8 * (ck) + i_; tok_ = tok_ > T - 1 ? T - 1 : tok_; \
            areg[i_] = *(const GAS bf16x8*)(qkv + (size_t)(b * T + tok_) * NS_N + colb + sc16 * 8); } } while (0)
#define CMP_BLOAD(dst, l2) do { _Pragma("unroll") for (int q_ = 0; q_ < 16; ++q_) dst[q_] = *(const GAS bf16x8*)(brow + (size_t)(16 * (l2) + q_) * 512); } while (0)
        CMP_ALOAD(0);
        bf16x8 bA[16], bB[16];
        CMP_BLOAD(bA, 0);
        __syncthreads();
        for (int ck = 0; ck < 4; ++ck) {
#pragma unroll
            for (int i = 0; i < 8; ++i) *(bf16x8*)(abuf + i * 8192 + att::koff<128>(sn, sc16 * 16)) = areg[i];
            __syncthreads();
            if (ck < 3) CMP_ALOAD(ck + 1);
#pragma unroll
            for (int p = 0; p < 4; ++p) {
                const int l2 = ck * 4 + p;
                if (p & 1) { if (l2 + 1 < 16) CMP_BLOAD(bA, l2 + 1); } else { CMP_BLOAD(bB, l2 + 1); }
#pragma unroll
                for (int q = 0; q < 16; ++q) {
                    const bf16x8 av = *(const bf16x8*)(abuf + (2 * p + (q >> 3)) * 8192 + att::koff<128>(r32, ((q & 7) * 16 + hi * 8) * 2));
                    acc = __builtin_amdgcn_mfma_f32_32x32x16_bf16(av, (p & 1) ? bB[q] : bA[q], acc, 0, 0, 0);
                }
            }
            __syncthreads();
        }
#undef CMP_ALOAD
#undef CMP_BLOAD
        float bias = 0.f;
        { float bl[32];
#pragma unroll
          for (int l = 0; l < 32; ++l) bl[l] = ((const GAS float*)biasp)[l * 256 + 32 * wave + r32];
#pragma unroll
          for (int l = 0; l < 32; ++l) bias += bl[l]; }
#pragma unroll
        for (int r = 0; r < 16; ++r) hid[att::crow(r, hi) * 264 + 32 * wave + r32] = f2bf1(silu(acc[r] + bias));
        __syncthreads();
        if (wave < 4) {
            f32x16 o2;
#pragma unroll
            for (int r = 0; r < 16; ++r) o2[r] = 0.f;
            const bf16_t* b2 = w2t + (size_t)(32 * wave + r32) * 256 + hi * 8;
#pragma unroll
            for (int k0 = 0; k0 < 16; ++k0) {
                const bf16x8 av = *(const bf16x8*)(hid + r32 * 264 + k0 * 16 + hi * 8);
                const bf16x8 bv = *(const GAS bf16x8*)(b2 + k0 * 16);
                o2 = __builtin_amdgcn_mfma_f32_32x32x16_bf16(av, bv, o2, 0, 0, 0);
            }
#pragma unroll
            for (int r = 0; r < 16; ++r) outf[att::crow(r, hi) * 132 + 32 * wave + r32] = o2[r];
        }
        __syncthreads();
        {
            const int grp = lane >> 4, sub = lane & 15, row = wave * 4 + grp, nn = n0 + row;
            float x[8];
#pragma unroll
            for (int e = 0; e < 8; ++e) x[e] = outf[row * 132 + sub * 8 + e];
            if (kvi == 0) {
                int tok = 16 * nn + 31; tok = tok > T - 1 ? T - 1 : tok;
                norm_rope8<128>(x, kgain, (const float*)(wsb + WS_ROPE128) + (size_t)(b * T + tok) * 32, sub);
            }
            bf16_t* dst = (bf16_t*)(wsb + (kvi ? WS_VC : WS_KC)) + ((size_t)(b * 256 + nn) * 4 + g) * 128 + sub * 8;
            st8(dst, x);
        }
    }
    __syncthreads();
}

DI void nsa_gates(int L2, char* lds, int vcu, int G, int wave, int lane) {
    unsigned char* const wsb = arg_ws();
    const int r32 = lane & 31, hi = lane >> 5, kp = wave & 1, pr = wave >> 1;
    float* part = (float*)lds + (pr & 1) * (32 * 64);
    for (int base = 0; base < M / 32; base += 2 * G) {
        const int it = base + pr * G + vcu; const bool valid = wave < 4 && it < M / 32;
        const int row0 = it * 32;
        f32x16 a0, a1;
#pragma unroll
        for (int r = 0; r < 16; ++r) { a0[r] = 0.f; a1[r] = 0.f; }
        if (valid) {
            const bf16_t* hb = (const bf16_t*)(wsb + WS_HB); const bf16_t* wg = (const bf16_t*)(wsb + WS_WG + (size_t)L2 * SZ_WG);
            const bf16_t* ap = hb + (size_t)(row0 + r32) * 256 + hi * 8;     const bf16_t* b0 = wg + (size_t)r32 * DM + hi * 8; const bf16_t* b1 = b0 + (size_t)32 * DM;
#pragma unroll 8
            for (int kk = 0; kk < DM / 32; ++kk) { const int ks = kp * (DM / 32) + kk;
                const bf16x8 av = *(const GAS bf16x8*)(ap + (size_t)(ks >> 4) * ((size_t)M * 256) + (ks & 15) * 16), bv0 = *(const GAS bf16x8*)(b0 + ks * 16), bv1 = *(const GAS bf16x8*)(b1 + ks * 16);
                a0 = __builtin_amdgcn_mfma_f32_32x32x16_bf16(av, bv0, a0, 0, 0, 0);
                a1 = __builtin_amdgcn_mfma_f32_32x32x16_bf16(av, bv1, a1, 0, 0, 0);
            }
            if (kp) {
#pragma unroll
                for (int r = 0; r < 16; ++r) { part[r * 64 + lane] = a0[r]; part[(16 + r) * 64 + lane] = a1[r]; }
            }
        } else if (wave >= 4 && base == 0) nsa_normrope(L2, vcu * 4 + wave - 4, G * 4, lane);
        __syncthreads();
        if (valid && kp == 0) {
            const float* rowss = (const float*)(wsb + WS_ROWSS); float* gates = (float*)(wsb + WS_GATES);
#pragma unroll
            for (int r = 0; r < 16; ++r) { a0[r] += part[r * 64 + lane]; a1[r] += part[(16 + r) * 64 + lane]; }
            float s = 0.f;
#pragma unroll
            for (int q = 0; q < 16; ++q) s += ((const GAS float*)rowss)[(size_t)(hi * 16 + q) * M + row0 + r32];
            s = sum_xor32(s);
            const float rs = __builtin_amdgcn_rsqf(s * (1.0f / DM) + EPS);
#pragma unroll
            for (int r = 0; r < 16; ++r) { const int row = att::crow(r, hi); const float rr = __shfl(rs, row);
                ((GAS float*)gates)[(size_t)(row0 + row) * 48 + r32] = a0[r] * rr;
                if (r32 < 16) ((GAS float*)gates)[(size_t)(row0 + row) * 48 + 32 + r32] = a1[r] * rr; }
        }
        __syncthreads();
    }
}

struct MaskCmp { int t; DI bool ok(int, int n) const { return 16 * n + 31 <= t; } DI bool partial(int) const { return true; } DI bool rowok(int) const { return true; } };
struct MaskSel { int t, qt; unsigned long long sel;
    DI bool ok(int, int key) const { return key <= t; }
    DI bool partial(int j) const { return j >= qt; }
    DI bool rowok(int j) const { return ((sel >> j) & 1ull) != 0ull; } };
struct SeqBits { unsigned long long bits; DI bool first(int& j) const { if (!bits) return false; j = __builtin_ctzll(bits); return true; }
    DI bool next(int j, int& jn) const { const unsigned long long rest = j >= 63 ? 0ull : (bits >> (j + 1)); if (!rest) return false; jn = j + 1 + __builtin_ctzll(rest); return true; } };
constexpr int NSL_KV = 0, NSL_OST = 65536, NSL_IMP = 135168, NSL_WS = 151552, NSL_SEL = 153600;
static_assert(NSL_OST + 8 * 32 * 136 * 2 <= NSL_IMP && NSL_IMP + 8 * 2048 <= NSL_WS && NSL_SEL + 512 <= MISC_OFF, "nsa LDS map");
DI void nsa_stage_out(att::Core<128>& c, bf16_t* stg, float* ws, float fac, bool first, int r32, int hi) {
    if (hi == 0) ws[r32] = fac;
    LDS_WAIT();
#pragma unroll
    for (int r = 0; r < 16; ++r) { const int orow = att::crow(r, hi); const float f = ws[orow];
#pragma unroll
        for (int d0 = 0; d0 < 4; ++d0) { bf16_t* p = stg + orow * 136 + d0 * 32 + r32; float v = c.o[d0][r] * f; if (!first) v += bf2f(*p); *p = f2bf1(v); } }
    LDS_WAIT();
}
DI void nsa_attention(int L2, char* lds, int vcu, int G, int tid, int wave, int lane) {
#define NSA_QKV ((const bf16_t*)(arg_ws() + WS_ACT))
#define NSA_KC ((const bf16_t*)(arg_ws() + WS_KC))
#define NSA_VC ((const bf16_t*)(arg_ws() + WS_VC))
    const int r32 = lane & 31, hi = lane >> 5, tl = r32 >> 2, r = r32 & 3;
    float* ws = (float*)(lds + NSL_WS) + wave * 64;
    bf16_t* stg = (bf16_t*)(lds + NSL_OST) + wave * (32 * 136);
    float* imp = (float*)(lds + NSL_IMP) + wave * 512;
    unsigned long long* selm = (unsigned long long*)(lds + NSL_SEL);
    constexpr float C = 0.088388347648318440f * 1.4426950408889634f;
    const int nper = (G == 256) ? 4 : (1024 + G - 1) / G;
    for (int ui = 0; ui < nper; ++ui) {
        int bg, qt;
        if (G == 256) { const int s = vcu & 15; bg = vcu >> 4; qt = ui == 0 ? s : (ui == 1 ? 31 - s : (ui == 2 ? 32 + s : 63 - s)); }
        else { const int u = ui * G + vcu; if (u >= 1024) break; bg = u >> 6; qt = u & 63; }
        const int b = bg >> 2, g = bg & 3, t0 = qt * 64, t = t0 + 8 * wave + tl, h = 4 * g + r;
        const bf16_t* rowp = NSA_QKV + (size_t)(b * T + t) * NS_N;
        att::Core<128> c;
        att::load_q<128>(c, rowp + h * 128, hi);
        qnorm_rope<128>(c, arg_in<15>() + L2 * 128, (const float*)(arg_ws() + WS_ROPE128) + (size_t)(b * T + t) * 32, hi);
#define NSA_GATE(k_) sigmoidf_(((const GAS float*)(arg_ws() + WS_GATES))[(size_t)(b * T + t) * 48 + h + 16 * (k_)])
        const int ncmp_tiles = (4 * qt + 3 + 63) >> 6;
        {
            att::core_reset<128>(c, att::M_INIT, 0.f);
            SeqRange seq; seq.lo = 0; seq.hi = ncmp_tiles - 1;
            MaskCmp mk; mk.t = t;
            att::run_tiles<128, false>(c, lds + NSL_KV, ws, NSA_KC + (size_t)b * 256 * 512 + g * 128, NSA_VC + (size_t)b * 256 * 512 + g * 128, 512, seq, mk, KxNone(), tid, lane);
            const bool has = (t >= 31) && c.l_reg > 0.f;
            nsa_stage_out(c, stg, ws, has ? NSA_GATE(0) * fast_rcp(c.l_reg) : 0.f, true, r32, hi);
        }
        unsigned long long mysel, usel;
        if (qt < 16) { mysel = (2ull << qt) - 1ull; usel = mysel; }
        else {
            const float inv_l = (c.l_reg > 0.f) ? fast_rcp(c.l_reg) : 0.f, mC = -c.m_reg * C;
            float carry = 0.f;
            for (int j = 0; j < ncmp_tiles; ++j) {
                att::StgH<128> s; att::stg_ld<128>(s, NSA_KC + (size_t)(b * 256 + 64 * j) * 512 + g * 128, 512, tid);
                __syncthreads();
                att::stg_wrK<128>(s, lds + NSL_KV, tid);
                __syncthreads();
                f32x16 p0, p1; att::qkt<128>(p0, p1, lds + NSL_KV, c.qr, r32, hi);
#pragma unroll
                for (int q = 0; q < 16; ++q) { const int n = 64 * j + att::crow(q, hi);
                    p0[q] = (16 * n + 31 <= t) ? fast_exp2(fmaf(p0[q], C, mC)) * inv_l : 0.f;
                    p1[q] = (16 * (n + 32) + 31 <= t) ? fast_exp2(fmaf(p1[q], C, mC)) * inv_l : 0.f; }
                float own0[4], own1[4], pl0[4], pl1[4];
#pragma unroll
                for (int q = 0; q < 4; ++q) { own0[q] = (p0[4 * q] + p0[4 * q + 1]) + (p0[4 * q + 2] + p0[4 * q + 3]); own1[q] = (p1[4 * q] + p1[4 * q + 1]) + (p1[4 * q + 2] + p1[4 * q + 3]);
                    pl0[q] = __shfl_xor(p0[4 * q + 3], 32); pl1[q] = __shfl_xor(p1[4 * q + 3], 32); }
                if (hi == 1) {
#pragma unroll
                    for (int q = 0; q < 4; ++q) { own0[q] += pl0[q]; own1[q] += pl1[q]; }
                } else {
                    own0[0] += carry; own1[0] += pl0[3];
#pragma unroll
                    for (int q = 1; q < 4; ++q) { own0[q] += pl0[q - 1]; own1[q] += pl1[q - 1]; }
                    carry = pl1[3];
                }
#pragma unroll
                for (int q = 0; q < 4; ++q) { own0[q] += __shfl_xor(own0[q], 1); own0[q] += __shfl_xor(own0[q], 2); own1[q] += __shfl_xor(own1[q], 1); own1[q] += __shfl_xor(own1[q], 2); }
                if (r == 0) {
#pragma unroll
                    for (int q = 0; q < 4; ++q) { imp[tl * 64 + 16 * j + 2 * q + hi] = own0[q]; imp[tl * 64 + 16 * j + 8 + 2 * q + hi] = own1[q]; }
                }
            }
            LDS_WAIT();
            const int tk = lane >> 3, sub = lane & 7;
            float v[8]; int cnt[8];
#pragma unroll
            for (int e = 0; e < 8; ++e) { v[e] = imp[tk * 64 + 8 * e + sub]; cnt[e] = 0; }
            for (int J2 = 1; J2 <= qt - 2; ++J2) { const float x = imp[tk * 64 + J2];
#pragma unroll
                for (int e = 0; e < 8; ++e) { const int J = 8 * e + sub; cnt[e] += (x > v[e] || (x == v[e] && J2 < J)) ? 1 : 0; } }
            unsigned long long m64 = 0ull;
#pragma unroll
            for (int e = 0; e < 8; ++e) { const int J = 8 * e + sub;
                const bool sel = (J == 0) || (J == qt) || (J == qt - 1) || (J >= 1 && J <= qt - 2 && cnt[e] < 13);
                const unsigned long long bal = __ballot(sel);
                m64 |= ((bal >> (8 * tk)) & 0xffull) << (8 * e); }
            if (sub == 0) selm[wave * 8 + tk] = m64;
            __syncthreads();
            mysel = selm[wave * 8 + tl];
            unsigned long long uu = selm[lane];
#pragma unroll
            for (int o = 1; o < 64; o <<= 1) { const unsigned lo_ = __shfl_xor((unsigned)uu, o), hi_ = __shfl_xor((unsigned)(uu >> 32), o); uu |= ((unsigned long long)hi_ << 32) | lo_; }
            usel = ((unsigned long long)__builtin_amdgcn_readfirstlane((unsigned)(uu >> 32)) << 32) | (unsigned)__builtin_amdgcn_readfirstlane((unsigned)uu);
        }
        {
            att::core_reset<128>(c, att::M_INIT, 0.f);
            SeqBits seq; seq.bits = usel;
            MaskSel mk; mk.t = t; mk.qt = qt; mk.sel = mysel;
            att::run_tiles<128, false>(c, lds + NSL_KV, ws, NSA_QKV + (size_t)b * T * NS_N + NS_KS + g * 128, NSA_QKV + (size_t)b * T * NS_N + NS_VS + g * 128, NS_N, seq, mk, KxNone(), tid, lane);
            nsa_stage_out(c, stg, ws, NSA_GATE(1) * fast_rcp(c.l_reg), false, r32, hi);
        }
        {
            att::core_reset<128>(c, att::M_INIT, 0.f);
            SeqRange seq; seq.lo = qt - 8 < 0 ? 0 : qt - 8; seq.hi = qt;
            MaskWin mk; mk.t = t; mk.w = 512; mk.tmin = t0; mk.tmax = t0 + 63;
            att::run_tiles<128, false>(c, lds + NSL_KV, ws, NSA_QKV + (size_t)b * T * NS_N + NS_KW + g * 128, NSA_QKV + (size_t)b * T * NS_N + NS_VW + g * 128, NS_N, seq, mk, KxNone(), tid, lane);
            nsa_stage_out(c, stg, ws, NSA_GATE(2) * fast_rcp(c.l_reg), false, r32, hi);
        }
#pragma unroll
        for (int i = 0; i < 8; ++i) { const int row = i * 4 + (lane >> 4), ch = lane & 15; const u32x4 v = *(const u32x4*)(stg + row * 136 + ch * 8);
            *(GAS u32x4*)((bf16_t*)(arg_ws() + WS_OB) + (size_t)(b * T + t0 + 8 * wave + (row >> 2)) * DM + (4 * g + (row & 3)) * 128 + ch * 8) = v; }
        LDS_WAIT();
        __syncthreads();
    }
}

#define GRID_BAR() do { XcdBarrier bar_; bar_.bar = (unsigned*)(arg_ws() + WS_CTL) + CW_BAR; bar_.x = xb_xcc_id(); bar_.st = (volatile LAS unsigned*)((LAS unsigned char*)lds + MISC_OFF) + 8; xcd_barrier(bar_); } while (0)
__global__ void __launch_bounds__(NWAVES * 64, 2) fwd_kernel(Args args) {
    extern __shared__ __attribute__((aligned(16))) unsigned char lds[];
    LAS unsigned char* ldsl = (LAS unsigned char*)lds;
    {
        const int tid = threadIdx.x;
        volatile LAS unsigned* MISC = (volatile LAS unsigned*)(ldsl + MISC_OFF);
        for (int u = tid; u < (LDS_BYTES - MISC_OFF) / 4; u += NWAVES * 64) MISC[u] = 0u;
        __syncthreads();
        (void)xcd_barrier_post((unsigned*)(arg_ws() + WS_CTL) + CW_BAR, MISC + 8);
    }
#define TIDV int tid_ = threadIdx.x; asm volatile("" : "+v"(tid_)); int G_ = gridDim.x, bx_ = blockIdx.x; asm volatile("" : "+s"(G_), "+s"(bx_)); const int tid = tid_, lane = tid & 63, wave = __builtin_amdgcn_readfirstlane(tid >> 6); const int G = G_, bx = bx_, vcu = (G % 8 == 0) ? (bx % 8) * (G / 8) + bx / 8 : bx; (void)tid; (void)lane; (void)wave; (void)vcu
#ifndef NO_PRO
    { TIDV; prologue(ldsl, vcu, G, wave, lane); }
#endif
    GRID_BAR();

    int stage = 0;
    for (int hl = 0; hl < 2 * DEPTH; ++hl) {
        if (stage < NSTAGES) {
#ifndef NO_S1
            {
                unsigned char* ws = arg_ws();
                pg8::Gemm g{(const bf16_t*)(ws + WS_HB), (const bf16_t*)(ws + WS_WFI + (size_t)hl * SZ_WFI), M, NFF, DM};
                pg8::StaticOrder S; { int G_ = gridDim.x, bx_ = blockIdx.x; asm volatile("" : "+s"(G_), "+s"(bx_)); S.init(M, NFF, G_, bx_); }
                pg8::cached_rs_reset();
                pg8::EpiSwiGLU E{(bf16_t*)(ws + WS_ACT), (const float*)(ws + WS_ROWSS)};
                pg8::gemm_phase<pg8::EpiSwiGLU, pg8::StaticOrder, DM, true, true, true>(ldsl, g, S, E);
            }
#endif
            GRID_BAR();
#ifndef NO_S2
            {
                unsigned char* ws = arg_ws(); float* out = (stage == 3 * DEPTH - 1) ? arg_out() : nullptr;
                pg8::Gemm g{(const bf16_t*)(ws + WS_ACT), (const bf16_t*)(ws + WS_WFO + (size_t)hl * SZ_WFO), M, DM, DFF};
                pg8::StaticOrder S; { int G_ = gridDim.x, bx_ = blockIdx.x; asm volatile("" : "+s"(G_), "+s"(bx_)); S.init(M, DM, G_, bx_); }
                pg8::EpiResid E{(bf16_t*)(ws + WS_HB), (bf16_t*)(ws + WS_LB), out, (float*)(ws + WS_ROWSS), 0.5f};
                pg8::gemm_phase<pg8::EpiResid, pg8::StaticOrder, DFF, false, true>(ldsl, g, S, E);
            }
#endif
            GRID_BAR();
        }
        ++stage;
        if ((hl & 1) == 0) {
            if (stage < NSTAGES) {
                const int L = hl >> 1, L2 = L >> 1; const bool swa = (L & 1) == 0;
#ifndef NO_S3
                {
                    unsigned char* ws = arg_ws();
                    const int N = swa ? SW_N : NS_N;
                    pg8::Gemm g{(const bf16_t*)(ws + WS_HB), (const bf16_t*)(swa ? ws + WS_WSI + (size_t)L2 * SZ_WSI : ws + WS_WNI + (size_t)L2 * SZ_WNI), M, N, DM};
                    pg8::StaticOrder S; { int G_ = gridDim.x, bx_ = blockIdx.x; asm volatile("" : "+s"(G_), "+s"(bx_)); S.init(M, N, G_, bx_); }
                    pg8::cached_rs_reset();
                    pg8::EpiScaleBf16 E{(bf16_t*)(ws + WS_ACT), N, (const float*)(ws + WS_ROWSS)};
                    pg8::gemm_phase<pg8::EpiScaleBf16, pg8::StaticOrder, DM, true, true, true>(ldsl, g, S, E);
                }
                if (swa) { TIDV;
                    const int nun = (M / 256) * (SW_N / 256), maxu = (nun + G - 1) / G, b0 = nun - (maxu - 1) * G;
                    if (b0 >= G) convert_deferred(ldsl, L2, bx, G, wave, lane);
                    else if (bx >= b0) convert_deferred(ldsl, L2, bx - b0, G - b0, wave, lane);
                }
#endif
                GRID_BAR();
                if (swa) {
#ifndef NO_SWA
                    { TIDV; swa_attention(L2, (char*)lds, vcu, G, tid, wave, lane); }
#endif
                } else {
#ifndef NO_NSAC
                    { TIDV; nsa_compress(L2, (char*)lds, vcu, G, tid, wave, lane);
                      nsa_gates(L2, (char*)lds, vcu, G, wave, lane); }
#endif
                    GRID_BAR();
#ifndef NO_NSAA
                    { TIDV; nsa_attention(L2, (char*)lds, vcu, G, tid, wave, lane); }
#endif
                }
                GRID_BAR();
#ifndef NO_S4
                {
                    unsigned char* ws = arg_ws();
                    pg8::Gemm g{(const bf16_t*)(ws + WS_OB), (const bf16_t*)(swa ? ws + WS_WSO + (size_t)L2 * SZ_WO : ws + WS_WNO + (size_t)L2 * SZ_WO), M, DM, DM};
                    pg8::StaticOrder S; { int G_ = gridDim.x, bx_ = blockIdx.x; asm volatile("" : "+s"(G_), "+s"(bx_)); S.init(M, DM, G_, bx_); }
                    pg8::EpiResid E{(bf16_t*)(ws + WS_HB), (bf16_t*)(ws + WS_LB), nullptr, (float*)(ws + WS_ROWSS), 1.0f};
                    pg8::gemm_phase<pg8::EpiResid, pg8::StaticOrder, DM, false, true>(ldsl, g, S, E);
                }
#endif
                GRID_BAR();
            }
            ++stage;
        }
    }
    (void)args;
}

extern "C" void kernel_launch(void* const* d_in, const int* in_sizes, int n_in, void* d_out, int out_size, void* d_ws, size_t ws_size, hipStream_t stream) {
    static int grid = 0;
    if (grid == 0) {
        if (n_in != 24 || in_sizes[0] != M * DM || out_size != M * DM || ws_size < WS_END) {
            fprintf(stderr, "kernel_launch: shape mismatch n_in %d in0 %d out %d ws %zu (need %zu)\n", n_in, n_in > 0 ? in_sizes[0] : -1, out_size, ws_size, (size_t)WS_END); grid = -1; return; }
        int dev = 0, cus = 0;
        if (hipGetDevice(&dev) != hipSuccess || hipDeviceGetAttribute(&cus, hipDeviceAttributeMultiprocessorCount, dev) != hipSuccess) { grid = -1; return; }
        if (hipFuncSetAttribute((const void*)fwd_kernel, hipFuncAttributeMaxDynamicSharedMemorySize, LDS_BYTES) != hipSuccess) { fprintf(stderr, "kernel_launch: hipFuncSetAttribute failed\n"); grid = -1; return; }
        int per_cu = 0;
        if (hipOccupancyMaxActiveBlocksPerMultiprocessor(&per_cu, (const void*)fwd_kernel, NWAVES * 64, LDS_BYTES) != hipSuccess || per_cu < 1) {
            fprintf(stderr, "kernel_launch: occupancy query reports %d workgroups per CU\n", per_cu); }
        (void)hipGetLastError();
        grid = cus;
    }
    if (grid < 0) return;
    if (hipMemsetAsync((char*)d_ws + WS_CTL, 0, CTL_ZERO_BYTES, stream) != hipSuccess) return;
    Args a{};
    for (int i = 0; i < 24; ++i) a.in[i] = (const float*)d_in[i];
    a.out = (float*)d_out; a.ws = (unsigned char*)d_ws;
    hipLaunchKernelGGL(fwd_kernel, dim3(grid), dim3(NWAVES * 64), LDS_BYTES, stream, a);
    const hipError_t le = hipPeekAtLastError();
    if (le != hipSuccess) fprintf(stderr, "kernel_launch: launch failed: %s\n", hipGetErrorName(le));
}
```

```cpp
#include <hip/hip_runtime.h>
#include <cstdio>
#include <cstdint>

#define DI __device__ __forceinline__
#define GAS __attribute__((address_space(1)))
#define LAS __attribute__((address_space(3)))

#ifndef RES_LO
#define RES_LO 0
#endif
#ifndef NSTAGES
#define NSTAGES 12
#endif

typedef unsigned short bf16_t;
typedef short bf16x8 __attribute__((ext_vector_type(8)));
typedef short s16x4 __attribute__((ext_vector_type(4)));
typedef float f32x4 __attribute__((ext_vector_type(4)));
typedef float f32x2 __attribute__((ext_vector_type(2)));
typedef float f32x16 __attribute__((ext_vector_type(16)));
typedef unsigned u32x4 __attribute__((ext_vector_type(4)));
typedef unsigned u32x2 __attribute__((ext_vector_type(2)));

constexpr int NB = 4, T = 4096, DM = 2048, M = NB * T, DFF = 5632, NFF = 2 * DFF, DEPTH = 4;
constexpr int SW_N = 2560;
constexpr int NS_NREAL = 5168, NS_N = 5120;
constexpr int NS_KC = 2048, NS_VC = 2560, NS_KS = 3072, NS_VS = 3584, NS_KW = 4096, NS_VW = 4608;
constexpr float EPS = 1e-6f;

constexpr size_t MiB = 1u << 20;
constexpr size_t al(size_t x) { return (x + MiB - 1) / MiB * MiB; }
constexpr size_t WS_CTL = 0, CTL_ZERO_BYTES = 32768;
constexpr size_t SZ_WFI = (size_t)NFF * DM * 2, SZ_WFO = (size_t)DM * DFF * 2, SZ_WSI = (size_t)SW_N * DM * 2, SZ_WO = (size_t)DM * DM * 2, SZ_WNI = (size_t)NS_N * DM * 2;
constexpr size_t SZ_W1 = (size_t)256 * 4096 * 2, SZ_W2 = (size_t)128 * 256 * 2, SZ_BIASP = (size_t)32 * 256 * 4;
constexpr size_t WS_WFI = 1 * MiB;
constexpr size_t WS_WFO = al(WS_WFI + 8 * SZ_WFI);
constexpr size_t WS_WSI = al(WS_WFO + 8 * SZ_WFO);
constexpr size_t WS_WSO = al(WS_WSI + 2 * SZ_WSI);
constexpr size_t WS_WNI = al(WS_WSO + 2 * SZ_WO);
constexpr size_t WS_WNO = al(WS_WNI + 2 * SZ_WNI);
constexpr size_t WS_W1 = al(WS_WNO + 2 * SZ_WO);
constexpr size_t WS_W2 = al(WS_W1 + 4 * SZ_W1);
constexpr size_t WS_BIASP = WS_W2 + 4 * SZ_W2;
constexpr size_t WS_ROPE64 = al(WS_BIASP + 4 * SZ_BIASP);
constexpr size_t WS_ROPE128 = al(WS_ROPE64 + (size_t)M * 16 * 4);
constexpr size_t WS_HB = al(WS_ROPE128 + (size_t)M * 32 * 4);
constexpr size_t WS_LB = al(WS_HB + (size_t)M * DM * 2);
constexpr size_t WS_ROWSS = al(WS_LB + (size_t)M * DM * 2);
constexpr size_t WS_ACT = al(WS_ROWSS + (size_t)M * 32 * 4);
constexpr size_t WS_OB = al(WS_ACT + (size_t)M * DFF * 2);
constexpr size_t WS_KC = al(WS_OB + (size_t)M * DM * 2);
constexpr size_t WS_VC = WS_KC + 1 * MiB;
constexpr size_t WS_WG = WS_VC + 1 * MiB;
constexpr size_t SZ_WG = (size_t)64 * DM * 2;
constexpr size_t WS_GATES = WS_WG + 1 * MiB;
constexpr size_t WS_END = WS_GATES + 4 * MiB;
static_assert((size_t)M * NS_N * 2 <= (size_t)M * DFF * 2, "nsa projections fit the activation region");

constexpr int CW_BAR = 4096;

constexpr int MISC_OFF = 154624;
constexpr int LDS_BYTES = 155648;
constexpr int NWAVES = 8;

DI unsigned cvtpk(float lo, float hi) { unsigned r; asm volatile("v_cvt_pk_bf16_f32 %0, %1, %2" : "=v"(r) : "v"(lo), "v"(hi)); return r; }
DI float bf2f(unsigned short b) { return __builtin_bit_cast(float, (unsigned)b << 16); }
DI float bflo(unsigned w) { return __builtin_bit_cast(float, w << 16); }
DI float bfhi(unsigned w) { return __builtin_bit_cast(float, w & 0xffff0000u); }
DI unsigned short f2bf1(float f) { return (unsigned short)(cvtpk(f, 0.f) & 0xffffu); }
DI float fast_rcp(float x) { return __builtin_amdgcn_rcpf(x); }
DI float fast_exp2(float x) { return __builtin_amdgcn_exp2f(x); }
DI float silu(float x) { return x * fast_rcp(1.f + fast_exp2(-1.4426950408889634f * x)); }
DI float sigmoidf_(float x) { return fast_rcp(1.f + fast_exp2(-1.4426950408889634f * x)); }
DI float sum_xor16(float s) { auto r = __builtin_amdgcn_permlane16_swap(__float_as_uint(s), __float_as_uint(s), false, false); return __uint_as_float(r[0]) + __uint_as_float(r[1]); }
DI float sum_xor32(float s) { auto r = __builtin_amdgcn_permlane32_swap(__float_as_uint(s), __float_as_uint(s), false, false); return __uint_as_float(r[0]) + __uint_as_float(r[1]); }
DI int lane_id_v() { int l; asm volatile("v_mbcnt_lo_u32_b32 %0, -1, 0\n\tv_mbcnt_hi_u32_b32 %0, -1, %0" : "=v"(l)); return l; }
#define LDS_WAIT() asm volatile("s_waitcnt lgkmcnt(0)" ::: "memory")
#define VM_WAIT() asm volatile("s_waitcnt vmcnt(0)" ::: "memory")

namespace pg8 {
constexpr int BM = 256, BK = 64, HALF = 128, HTB = HALF * BK * 2, STAGE_BYTES = 8 * HTB, NXCD = 8, WGM = 8;
__host__ __device__ __forceinline__ int lds_byte(int r, int c) { const int st = (r >> 4) * 2 + (c >> 5), rr = r & 15, cc = c & 31, ob = rr * 64 + cc * 2; return st * 1024 + (ob ^ (((ob >> 9) & 1) << 5)); }
__host__ __device__ __forceinline__ void stage_rc(int b, int& R, int& C) { const int st = b / 1024, sb = b % 1024, swz = sb ^ (((sb >> 9) & 1) << 5); R = (st >> 1) * 16 + swz / 64; C = (st & 1) * 32 + (swz % 64) / 2; }
__host__ __device__ __forceinline__ int perm32(int rho) { const int n = rho >> 4, i = rho & 15; return 8 * (i >> 2) + 4 * n + (i & 3); }
struct Unit { int pm, pn; };
struct Gemm { const bf16_t* A; const bf16_t* Bt; int M, N, K; };
struct StaticOrder {
    int nM, nN, nwg, G, c;
    __host__ __device__ void init(int M_, int N_, int G_, int c_) { nM = M_ / BM; nN = N_ / BM; nwg = nM * nN; G = G_; c = c_; }
    __host__ __device__ bool next(int i, Unit& u) const {
        const long L = (long)i * G + c; if (L >= nwg) return false;
        int wgid = (int)L; { const int q = nwg / NXCD, r = nwg % NXCD, xcd = wgid % NXCD, off = wgid / NXCD; wgid = (xcd < r ? xcd * (q + 1) : r * (q + 1) + (xcd - r) * q) + off; }
        const int nig = WGM * nN, gid = wgid / nig, fm = gid * WGM, gsz = (nM - fm) < WGM ? (nM - fm) : WGM;
        u.pm = fm + ((wgid % nig) % gsz); u.pn = (wgid % nig) / gsz; return true;
    }
    __device__ __forceinline__ void a_ready(const Unit&) const {}
    __device__ __forceinline__ void done(const Unit&) const {}
};

DI void load_rs(const float* rowss, int row0, int fq, float (&rs)[2][4]) {
    float a[2][4][8];
#pragma unroll
    for (int ai = 0; ai < 2; ++ai)
#pragma unroll
        for (int m = 0; m < 4; ++m)
#pragma unroll
            for (int q = 0; q < 8; ++q) a[ai][m][q] = ((const GAS float*)rowss)[(size_t)(fq * 8 + q) * M + row0 + ai * HALF + m * 16];
    asm volatile("" ::: "memory");
    float eps = EPS; asm volatile("" : "+v"(eps));
#pragma unroll
    for (int ai = 0; ai < 2; ++ai)
#pragma unroll
        for (int m = 0; m < 4; ++m) {
            float s = ((a[ai][m][0] + a[ai][m][1]) + (a[ai][m][2] + a[ai][m][3])) + ((a[ai][m][4] + a[ai][m][5]) + (a[ai][m][6] + a[ai][m][7]));
            s = sum_xor32(sum_xor16(s));
            rs[ai][m] = __builtin_amdgcn_rsqf(s * (1.0f / DM) + eps);
        }
}
constexpr int RSC_OFF = 131072, RSC_WAVE_BYTES = 1024;
DI void cached_rs(const float* rowss, int pm, int row0, int wid, int fr, int fq, float (&rs)[2][4]) {
    LAS float* slot = (LAS float*)(unsigned)(RSC_OFF + wid * RSC_WAVE_BYTES);
    const int tag = ((volatile LAS int*)slot)[0];
    if (__builtin_amdgcn_readfirstlane(tag) != pm) {
        load_rs(rowss, row0, fq, rs);
        if (fq == 0) {
#pragma unroll
            for (int ai = 0; ai < 2; ++ai)
#pragma unroll
                for (int m = 0; m < 4; ++m) slot[16 + 16 * (4 * ai + m) + fr] = rs[ai][m];
        }
        if (fq == 0 && fr == 0) ((volatile LAS int*)slot)[0] = pm;
    } else {
#pragma unroll
        for (int ai = 0; ai < 2; ++ai)
#pragma unroll
            for (int m = 0; m < 4; ++m) rs[ai][m] = slot[16 + 16 * (4 * ai + m) + fr];
    }
}
DI void cached_rs_reset(int wid) {
    if (lane_id_v() == 0) ((volatile LAS int*)(unsigned)(RSC_OFF + wid * RSC_WAVE_BYTES))[0] = -1;
}
struct EpiSwiGLU {
    static constexpr bool PERM = true, AFTER_DRAIN = false, WIDE = false;
    bf16_t* O; const float* rowss;
    DI void operator()(const f32x4 (&acc)[2][2][4][2], const Unit& u, int wr, int wc, int fr, int fq) const {
        const int row0 = u.pm * BM + wr * 64 + fr, col0 = u.pn * HALF + wc * 32 + 8 * fq;
        float rs[2][4]; cached_rs(rowss, u.pm, row0, wr * 4 + wc, fr, fq, rs);
#pragma unroll
        for (int ai = 0; ai < 2; ++ai)
#pragma unroll
            for (int m = 0; m < 4; ++m) {
                const float r = rs[ai][m], rn = -1.4426950408889634f * r, r2 = r * r;
                u32x4 w;
#pragma unroll
                for (int n = 0; n < 2; ++n)
#pragma unroll
                    for (int h2 = 0; h2 < 2; ++h2) {
                        const f32x2 g = {acc[ai][0][m][n][2 * h2], acc[ai][0][m][n][2 * h2 + 1]}, uu = {acc[ai][1][m][n][2 * h2], acc[ai][1][m][n][2 * h2 + 1]};
                        f32x2 t = g * rn; t = __builtin_elementwise_min(t, (f32x2){60.f, 60.f});
                        f32x2 d; d.x = fast_exp2(t.x); d.y = fast_exp2(t.y); d = d + 1.0f;
                        const float R = fast_rcp(d.x * d.y);
                        const f32x2 q = (f32x2){d.y, d.x} * R;
                        const f32x2 o = ((g * uu) * r2) * q;
                        const unsigned pk = cvtpk(o.x, o.y);
                        if (n == 0) { if (h2 == 0) w.x = pk; else w.y = pk; } else { if (h2 == 0) w.z = pk; else w.w = pk; }
                    }
                *(GAS u32x4*)(O + (size_t)(row0 + ai * HALF + m * 16) * DFF + col0) = w;
            }
    }
};
struct EpiScaleBf16 {
    static constexpr bool PERM = true, AFTER_DRAIN = false, WIDE = false;
    bf16_t* O; int ldc; const float* rowss;
    DI void operator()(const f32x4 (&acc)[2][2][4][2], const Unit& u, int wr, int wc, int fr, int fq) const {
        const int row0 = u.pm * BM + wr * 64 + fr, col0 = u.pn * BM + wc * 32 + 8 * fq;
        float rs[2][4]; cached_rs(rowss, u.pm, row0, wr * 4 + wc, fr, fq, rs);
#pragma unroll
        for (int ai = 0; ai < 2; ++ai)
#pragma unroll
            for (int m = 0; m < 4; ++m) {
                const float r = rs[ai][m]; bf16_t* rowp = O + (size_t)(row0 + ai * HALF + m * 16) * ldc + col0;
#pragma unroll
                for (int bj = 0; bj < 2; ++bj) { const f32x4 v0 = acc[ai][bj][m][0] * r, v1 = acc[ai][bj][m][1] * r;
                    u32x4 w; w.x = cvtpk(v0[0], v0[1]); w.y = cvtpk(v0[2], v0[3]); w.z = cvtpk(v1[0], v1[1]); w.w = cvtpk(v1[2], v1[3]);
                    *(GAS u32x4*)(rowp + bj * HALF) = w; }
            }
    }
};
struct EpiResid {
    static constexpr bool PERM = true, AFTER_DRAIN = false, WIDE = true;
    bf16_t* hi; bf16_t* lo; float* out; float* rowss; float scale;
    DI void operator()(const f32x4 (&acc)[2][2][4][2], const Unit& u, int wr, int wc, int fr, int fq) const {
        const int row0 = u.pm * BM + wr * 64 + fr, col0 = u.pn * BM + wc * 64 + 8 * fq;
        const size_t hbase = (size_t)u.pn * ((size_t)M * 256) + wc * 64 + 8 * fq;
        u32x4 H[2][4][2];
#pragma unroll
        for (int ai = 0; ai < 2; ++ai)
#pragma unroll
            for (int m = 0; m < 4; ++m)
#pragma unroll
                for (int bj = 0; bj < 2; ++bj) H[ai][m][bj] = *(const GAS u32x4*)(hi + hbase + (size_t)(row0 + ai * HALF + m * 16) * 256 + bj * 32);
        asm volatile("" ::: "memory");
#pragma unroll
        for (int ai = 0; ai < 2; ++ai) {
#pragma unroll
            for (int m = 0; m < 4; ++m) {
                const int r = row0 + ai * HALF + m * 16; const size_t off = (size_t)r * DM + col0; float ss = 0.f;
#pragma unroll
                for (int bj = 0; bj < 2; ++bj) {
                    const u32x4 h = H[ai][m][bj];
                    const f32x4 a0 = acc[ai][bj][m][0], a1 = acc[ai][bj][m][1];
                    float v[8];
                    v[0] = bflo(h.x) + a0[0] * scale; v[1] = bfhi(h.x) + a0[1] * scale;
                    v[2] = bflo(h.y) + a0[2] * scale; v[3] = bfhi(h.y) + a0[3] * scale;
                    v[4] = bflo(h.z) + a1[0] * scale; v[5] = bfhi(h.z) + a1[1] * scale;
                    v[6] = bflo(h.w) + a1[2] * scale; v[7] = bfhi(h.w) + a1[3] * scale;
#pragma unroll
                    for (int e = 0; e < 8; ++e) ss += v[e] * v[e];
                    u32x4 nh;
                    nh.x = cvtpk(v[0], v[1]); nh.y = cvtpk(v[2], v[3]); nh.z = cvtpk(v[4], v[5]); nh.w = cvtpk(v[6], v[7]);
                    *(GAS u32x4*)(hi + hbase + (size_t)r * 256 + bj * 32) = nh;
                    if (out) { *(GAS f32x4*)(out + off + bj * 32) = (f32x4){v[0], v[1], v[2], v[3]}; *(GAS f32x4*)(out + off + bj * 32 + 4) = (f32x4){v[4], v[5], v[6], v[7]}; }
                }
                ss = sum_xor32(sum_xor16(ss));
                if (fq == 0) ((GAS float*)rowss)[(size_t)(u.pn * 4 + wc) * M + r] = ss;
            }
        }
    }
};

template <class Epi, class Sched, int KC, bool ALIGN_EPI = false, bool SP2 = false, bool ATILED = false>
__device__ __forceinline__ void gemm_phase(LAS unsigned char* lds, const Gemm g, const Sched& S, const Epi& E, int wave_s) {
    int tid_ = wave_s * 64 + lane_id_v(); asm volatile("" : "+v"(tid_));
    const int tid = tid_, wid = __builtin_amdgcn_readfirstlane(tid >> 6), lane = tid & 63, wr = wid >> 2, wc = wid & 3, fr = lane & 15, fq = lane >> 4;
    constexpr int K = KC, nt = K / BK;
    unsigned voffA[2], voffB[2];
#pragma unroll
    for (int i = 0; i < 2; ++i) { int R, C; stage_rc(tid * 16 + i * 8192, R, C);
        const int Rb = Epi::WIDE ? (64 * (R >> 5) + perm32(R & 31)) : (Epi::PERM ? ((R & ~31) + perm32(R & 31)) : R);
        voffA[i] = ATILED ? (unsigned)(R * 256 + C) * 2u : (unsigned)(R * K + C) * 2u; voffB[i] = (unsigned)(Rb * K + C) * 2u; }
    const size_t kstep = (size_t)(BK * 2);
    const size_t hstep = (size_t)HALF * K * 2;
    const size_t hstepB = Epi::WIDE ? (size_t)32 * K * 2 : hstep;
    const size_t tstep = 2 * hstep;
    const size_t hstepA = ATILED ? (size_t)HALF * 512 : hstep, tstepA = 2 * hstepA;
    const size_t panelA = (size_t)g.M * 512;
#define PG8_AOFF(t_) (ATILED ? (size_t)((t_) >> 2) * panelA + (size_t)((t_) & 3) * kstep : (size_t)(t_) * kstep)
    const unsigned ldsw = (unsigned)wid * 1024u;
    const int aoff = lds_byte(wr * 64 + fr, fq * 8), boff = lds_byte(wc * 32 + fr, fq * 8);
#define PG8_SA(b, h) (((b) * 2 + (h)) * HTB)
#define PG8_SB(b, h) ((4 + (b) * 2 + (h)) * HTB)
#define PG8_STAGE(bufoff, gbase, voff) do { _Pragma("unroll") for (int _i = 0; _i < 2; ++_i) \
        __builtin_amdgcn_global_load_lds((const unsigned*)((const char*)(gbase) + (voff)[_i]), (LAS unsigned*)(lds + (bufoff) + ldsw + _i * 8192), 16, 0, 0); } while (0)
#define PG8_LDA(dst, b, h) do { _Pragma("unroll") for (int m = 0; m < 4; ++m) _Pragma("unroll") for (int k = 0; k < 2; ++k) dst[m][k] = *(const LAS bf16x8*)(lds + PG8_SA(b, h) + aoff + m * 2048 + k * 1024); } while (0)
#define PG8_LDB(dst, b, h) do { _Pragma("unroll") for (int n = 0; n < 2; ++n) _Pragma("unroll") for (int k = 0; k < 2; ++k) dst[n][k] = *(const LAS bf16x8*)(lds + PG8_SB(b, h) + boff + n * 2048 + k * 1024); } while (0)
#define PG8_MMA(ai, bj, At, Bt) do { __builtin_amdgcn_s_setprio(1); _Pragma("unroll") for (int m = 0; m < 4; ++m) _Pragma("unroll") for (int n = 0; n < 2; ++n) _Pragma("unroll") for (int k = 0; k < 2; ++k) \
        acc[ai][bj][m][n] = __builtin_amdgcn_mfma_f32_16x16x32_bf16(Bt[n][k], At[m][k], acc[ai][bj][m][n], 0, 0, 0); __builtin_amdgcn_s_setprio(0); } while (0)
#define PG8_WAIT_V(n) asm volatile("s_waitcnt vmcnt(" #n ")" ::: "memory")
#define PG8_WAIT_L(n) asm volatile("s_waitcnt lgkmcnt(" #n ")" ::: "memory")
#define PG8_BAR __builtin_amdgcn_s_barrier()
#define PG8_SCHED __builtin_amdgcn_sched_barrier(0)
    Unit cur, nxt; int ui = 0;
    if (!S.next(0, cur)) return;
    f32x4 acc[2][2][4][2];
#pragma unroll
    for (int a = 0; a < 2; ++a)
#pragma unroll
        for (int b = 0; b < 2; ++b)
#pragma unroll
            for (int m = 0; m < 4; ++m)
#pragma unroll
                for (int n = 0; n < 2; ++n) acc[a][b][m][n] = (f32x4){0.f, 0.f, 0.f, 0.f};
    bf16x8 At[4][2], B0[2][2], B1[2][2];
    const char* cA = (const char*)g.A + (size_t)cur.pm * tstepA; const char* cB = (const char*)g.Bt + (size_t)cur.pn * tstep;
    S.a_ready(cur);
    if constexpr (SP2) {
        PG8_STAGE(PG8_SB(0, 0), cB, voffB); PG8_STAGE(PG8_SB(0, 1), cB + hstepB, voffB); PG8_STAGE(PG8_SA(0, 0), cA, voffA); PG8_STAGE(PG8_SA(0, 1), cA + hstepA, voffA);
        if (wr == 1) PG8_BAR;
        PG8_WAIT_V(2); PG8_BAR;
        PG8_STAGE(PG8_SB(1, 0), cB + kstep, voffB); PG8_STAGE(PG8_SA(1, 0), cA + kstep, voffA); PG8_STAGE(PG8_SB(1, 1), cB + hstepB + kstep, voffB);
        PG8_WAIT_V(6); PG8_BAR;
    } else {
        PG8_STAGE(PG8_SB(0, 0), cB, voffB); PG8_STAGE(PG8_SA(0, 0), cA, voffA); PG8_STAGE(PG8_SB(0, 1), cB + hstepB, voffB); PG8_STAGE(PG8_SA(0, 1), cA + hstepA, voffA);
        if (wr == 1) PG8_BAR;
        PG8_WAIT_V(4); PG8_BAR;
        PG8_STAGE(PG8_SB(1, 0), cB + kstep, voffB); PG8_STAGE(PG8_SA(1, 0), cA + kstep, voffA); PG8_STAGE(PG8_SB(1, 1), cB + hstepB + kstep, voffB);
        PG8_WAIT_V(6); PG8_BAR;
    }
    for (;;) {
        const bool has_next = S.next(ui + 1, nxt);
        const char* nA = has_next ? (const char*)g.A + (size_t)nxt.pm * tstepA : cA; const char* nB = has_next ? (const char*)g.Bt + (size_t)nxt.pn * tstep : cB;
        for (int t = 0; t < nt; t += 2) {
            const bool last = (t == nt - 2);
            const char* a1 = cA + PG8_AOFF(t + 1);
            const char* a2 = last ? nA : cA + PG8_AOFF(t + 2); const char* b2 = last ? nB : cB + (size_t)(t + 2) * kstep;
            const char* a3 = a2 + kstep; const char* b3 = b2 + kstep;
            if (last && has_next) S.a_ready(nxt);
            if constexpr (SP2) {
            PG8_LDB(B0, 0, 0); PG8_LDB(B1, 0, 1); PG8_SCHED; PG8_LDA(At, 0, 0); PG8_STAGE(PG8_SA(1, 1), a1 + hstepA, voffA);
            PG8_WAIT_V(8); PG8_WAIT_L(0); PG8_BAR; PG8_MMA(0, 0, At, B0); PG8_MMA(0, 1, At, B1); PG8_BAR; PG8_SCHED;
            PG8_LDA(At, 0, 1); PG8_STAGE(PG8_SB(0, 0), b2, voffB); PG8_STAGE(PG8_SB(0, 1), b2 + hstepB, voffB); PG8_STAGE(PG8_SA(0, 0), a2, voffA);
            PG8_WAIT_V(8); PG8_WAIT_L(0); PG8_BAR; PG8_MMA(1, 0, At, B0); PG8_MMA(1, 1, At, B1); PG8_BAR; PG8_SCHED;
            PG8_LDB(B0, 1, 0); PG8_LDB(B1, 1, 1); PG8_SCHED; PG8_LDA(At, 1, 0); PG8_STAGE(PG8_SA(0, 1), a2 + hstepA, voffA);
            PG8_WAIT_V(8); PG8_WAIT_L(0); PG8_BAR; PG8_MMA(0, 0, At, B0); PG8_MMA(0, 1, At, B1); PG8_BAR; PG8_SCHED;
            PG8_LDA(At, 1, 1); PG8_STAGE(PG8_SB(1, 0), b3, voffB); PG8_STAGE(PG8_SB(1, 1), b3 + hstepB, voffB); PG8_STAGE(PG8_SA(1, 0), a3, voffA);
            PG8_WAIT_V(8); PG8_WAIT_L(0); PG8_BAR; PG8_MMA(1, 0, At, B0); PG8_MMA(1, 1, At, B1); PG8_BAR; PG8_SCHED;
            } else {
            PG8_LDB(B0, 0, 0); PG8_SCHED; PG8_LDA(At, 0, 0); PG8_STAGE(PG8_SA(1, 1), a1 + hstepA, voffA);
            PG8_WAIT_L(8); PG8_BAR; PG8_WAIT_L(0); PG8_MMA(0, 0, At, B0); PG8_BAR; PG8_SCHED;
            PG8_LDB(B1, 0, 1); PG8_STAGE(PG8_SB(0, 0), b2, voffB);
            PG8_BAR; PG8_WAIT_L(0); PG8_MMA(0, 1, At, B1); PG8_BAR;
            PG8_LDA(At, 0, 1); PG8_STAGE(PG8_SA(0, 0), a2, voffA);
            PG8_BAR; PG8_WAIT_L(0); PG8_MMA(1, 0, At, B0); PG8_BAR; PG8_SCHED;
            PG8_STAGE(PG8_SB(0, 1), b2 + hstepB, voffB);
            PG8_WAIT_V(6); PG8_BAR; PG8_MMA(1, 1, At, B1); PG8_BAR;
            PG8_LDB(B0, 1, 0); PG8_SCHED; PG8_LDA(At, 1, 0); PG8_STAGE(PG8_SA(0, 1), a2 + hstepA, voffA);
            PG8_WAIT_L(8); PG8_BAR; PG8_WAIT_L(0); PG8_MMA(0, 0, At, B0); PG8_BAR; PG8_SCHED;
            PG8_LDB(B1, 1, 1); PG8_STAGE(PG8_SB(1, 0), b3, voffB);
            PG8_BAR; PG8_WAIT_L(0); PG8_MMA(0, 1, At, B1); PG8_BAR;
            PG8_LDA(At, 1, 1); PG8_STAGE(PG8_SA(1, 0), a3, voffA);
            PG8_BAR; PG8_WAIT_L(0); PG8_MMA(1, 0, At, B0); PG8_BAR; PG8_SCHED;
            PG8_STAGE(PG8_SB(1, 1), b3 + hstepB, voffB);
            PG8_WAIT_V(6); PG8_BAR; PG8_MMA(1, 1, At, B1); PG8_BAR;
            }
        }
        if constexpr (ALIGN_EPI) { if (wr == 0) PG8_BAR; }
        if constexpr (!Epi::AFTER_DRAIN) { E(acc, cur, wr, wc, fr, fq); S.done(cur); }
        if (!has_next) break;
#pragma unroll
        for (int a = 0; a < 2; ++a)
#pragma unroll
            for (int b = 0; b < 2; ++b)
#pragma unroll
                for (int m = 0; m < 4; ++m)
#pragma unroll
                    for (int n = 0; n < 2; ++n) acc[a][b][m][n] = (f32x4){0.f, 0.f, 0.f, 0.f};
        cur = nxt; cA = nA; cB = nB; ++ui;
        if constexpr (ALIGN_EPI) { if (wr == 1) PG8_BAR; }
    }
    PG8_WAIT_V(0);
    if constexpr (!ALIGN_EPI) { if (wr == 0) PG8_BAR; }
    PG8_BAR;
#undef PG8_AOFF
#undef PG8_SA
#undef PG8_SB
#undef PG8_STAGE
#undef PG8_LDA
#undef PG8_LDB
#undef PG8_MMA
#undef PG8_WAIT_V
#undef PG8_WAIT_L
#undef PG8_BAR
#undef PG8_SCHED
}
}

#define XB_TMO      128
#define XB_XCNT(j)  (256  + 64 * (j))
#define XB_XSUB(j)  (1280 + 64 * (j))
#define XB_XGEN(j)  (2304 + 64 * (j))
#define XB_TOP      3328
#define XB_TOPGEN   3392
#define XCD_BAR_WORDS 3456
#define XB_SPIN_CAP (1u << 18)
__device__ __forceinline__ unsigned xb_ld(unsigned* p)              { return __hip_atomic_load(p, __ATOMIC_RELAXED, __HIP_MEMORY_SCOPE_AGENT); }
__device__ __forceinline__ unsigned xb_add(unsigned* p, unsigned v) { return __hip_atomic_fetch_add(p, v, __ATOMIC_RELAXED, __HIP_MEMORY_SCOPE_AGENT); }
__device__ __forceinline__ unsigned xb_xcc_id() { return (unsigned)__builtin_amdgcn_s_getreg((3 << 11) | 20) & 0xFu; }
#define XB_SPIN(cond, bar) do { unsigned _sp = 0; while (cond) { __builtin_amdgcn_s_sleep(1); \
    if ((++_sp & 255u) == 0u) { if (xb_ld(&(bar)[XB_TMO])) break; if (_sp > XB_SPIN_CAP) { atomicAdd(&(bar)[XB_TMO], 1u); break; } } } } while (0)
struct XcdBarrier { unsigned* bar; unsigned x; volatile LAS unsigned* st; };
__device__ __forceinline__ XcdBarrier xcd_barrier_post(unsigned* bar, volatile LAS unsigned* st) {
    XcdBarrier b; b.bar = bar; b.x = xb_xcc_id(); b.st = st;
    if (threadIdx.x == 0) (void)xb_add(&bar[XB_XCNT(b.x)], 1u);
    return b;
}
__device__ __forceinline__ void xcd_barrier_complete(unsigned* bar, unsigned x, unsigned& nloc, unsigned& nx) {
    const unsigned G = gridDim.x * gridDim.y * gridDim.z;
    unsigned sum, cnt, mine, sp = 0u;
    for (;;) {
        sum = 0u; cnt = 0u; mine = 0u;
#pragma unroll
        for (unsigned j = 0; j < 16; ++j) { const unsigned c = xb_ld(&bar[XB_XCNT(j)]); sum += c; cnt += (c > 0u) ? 1u : 0u; mine = (j == x) ? c : mine; }
        if (sum == G) break;
        __builtin_amdgcn_s_sleep(1);
        if ((++sp & 255u) == 0u) { if (xb_ld(&bar[XB_TMO])) break; if (sp > XB_SPIN_CAP) { atomicAdd(&bar[XB_TMO], 1u); break; } }
    }
    nloc = mine > 0u ? mine : 1u; nx = cnt > 0u ? cnt : 1u;
}
__device__ __forceinline__ void xcd_barrier(const XcdBarrier& b, bool thread0) {
    asm volatile("s_waitcnt vmcnt(0)" ::: "memory");
    __syncthreads();
    if (thread0) {
        unsigned* bar = b.bar;
        __builtin_amdgcn_s_waitcnt(0);
        unsigned nloc = b.st[0], nx = b.st[1];
        if (nloc == 0u) { xcd_barrier_complete(bar, b.x, nloc, nx); b.st[0] = nloc; b.st[1] = nx; }
        const unsigned old = xb_add(&bar[XB_XSUB(b.x)], 1u);
        const unsigned gen = old / nloc;
        if (old + 1u == (gen + 1u) * nloc) {
            __builtin_amdgcn_fence(__ATOMIC_RELEASE, "agent");
            asm volatile("s_waitcnt vmcnt(0)" ::: "memory");
            const unsigned og = xb_add(&bar[XB_TOP], 1u);
            const unsigned tg = og / nx;
            if (og + 1u == (tg + 1u) * nx) xb_add(&bar[XB_TOPGEN], 1u);
            else XB_SPIN(xb_ld(&bar[XB_TOPGEN]) == tg, bar);
            __builtin_amdgcn_fence(__ATOMIC_ACQUIRE, "agent");
            xb_add(&bar[XB_XGEN(b.x)], 1u);
            asm volatile("s_waitcnt vmcnt(0)" ::: "memory");
        } else {
            XB_SPIN(xb_ld(&bar[XB_XGEN(b.x)]) == gen, bar);
            __builtin_amdgcn_fence(__ATOMIC_ACQUIRE, "agent");
            asm volatile("s_waitcnt vmcnt(0)" ::: "memory");
        }
    }
    __syncthreads();
}

__device__ __forceinline__ void xcd_barrier_local(const XcdBarrier& b, bool thread0) {
    asm volatile("s_waitcnt vmcnt(0)" ::: "memory");
    __syncthreads();
    if (thread0) {
        unsigned* bar = b.bar;
        __builtin_amdgcn_s_waitcnt(0);
        const unsigned nloc = b.st[0];
        const unsigned old = xb_add(&bar[XB_XSUB(b.x)], 1u);
        const unsigned gen = old / nloc;
        if (old + 1u == (gen + 1u) * nloc) xb_add(&bar[XB_XGEN(b.x)], 1u);
        else XB_SPIN(xb_ld(&bar[XB_XGEN(b.x)]) == gen, bar);
        __builtin_amdgcn_fence(__ATOMIC_ACQUIRE, "agent");
        asm volatile("s_waitcnt vmcnt(0)" ::: "memory");
    }
    __syncthreads();
}

namespace att {
#define SBAR() __builtin_amdgcn_sched_barrier(0)
constexpr float NEGS = -1e30f;
constexpr float M_INIT = -30000.f;
DI int crow(int r, int hi) { return (r & 3) + 8 * (r >> 2) + 4 * hi; }
template <int D> DI int koff(int row, int cb) { return row * (2 * D) + (cb ^ ((row & 7) << 4)); }
template <int D> DI int v_st(int k, int c) { const int kk = (k & ~0xC) | ((k & 4) << 1) | ((k & 8) >> 1); return ((kk >> 3) * (D / 32) + (c >> 5)) * 512 + ((kk & 7) * 32 + (c & 31)) * 2; }
DI int v_rd_base(int lane) { return ((lane & 3) << 3) | (((lane >> 2) & 3) << 6) | (((lane >> 4) & 1) << 5) | (((lane >> 5) & 1) << 8); }
template <int D> constexpr int v_rd_off(int d0, int ks, int half) { return d0 * 512 + ks * (2 * (D / 32) * 512) + half * ((D / 32) * 512); }
template <int OFF> DI s16x4 tr_read(int vb) { s16x4 r; asm volatile("ds_read_b64_tr_b16 %0, %1 offset:%2" : "=&v"(r) : "v"(vb), "i"(OFF) : "memory"); return r; }

template <int D> struct Core {
    float m_reg, l_reg; f32x16 o[D / 32]; bf16x8 qr[D / 16];
};
template <int D> DI void core_reset(Core<D>& c, float m0, float l0) {
    c.m_reg = m0; c.l_reg = l0;
#pragma unroll
    for (int d = 0; d < D / 32; ++d)
#pragma unroll
        for (int r = 0; r < 16; ++r) c.o[d][r] = 0.f;
}
template <int D> DI void load_q(Core<D>& c, const bf16_t* qrow, int hi) {
#pragma unroll
    for (int d0 = 0; d0 < D / 16; ++d0) c.qr[d0] = *(const GAS bf16x8*)(qrow + d0 * 16 + hi * 8);
}
template <int D, int NBT = 4> DI void qkt(f32x16& p0, f32x16& p1, const char* Ks, const bf16x8* qr, int r32, int hi) {
#pragma unroll
    for (int r = 0; r < 16; ++r) { p0[r] = 0.f; p1[r] = 0.f; }
    int rowb = r32 * (2 * D), swz = (r32 & 7) << 4; asm volatile("" : "+v"(rowb), "+v"(swz));
#pragma unroll
    for (int g4 = 0; g4 < D / (16 * NBT); ++g4) {
        bf16x8 kf[2 * NBT];
#pragma unroll
        for (int i = 0; i < NBT; ++i) { const int cb = ((g4 * NBT + i) * 16 + hi * 8) * 2;
            const char* kp = Ks + rowb + (cb ^ swz);
            kf[2 * i] = *reinterpret_cast<const bf16x8*>(kp);
            kf[2 * i + 1] = *reinterpret_cast<const bf16x8*>(kp + 64 * D); }
        SBAR();
#pragma unroll
        for (int i = 0; i < NBT; ++i) {
            p0 = __builtin_amdgcn_mfma_f32_32x32x16_bf16(kf[2 * i], qr[g4 * NBT + i], p0, 0, 0, 0);
            p1 = __builtin_amdgcn_mfma_f32_32x32x16_bf16(kf[2 * i + 1], qr[g4 * NBT + i], p1, 0, 0, 0); }
        SBAR();
    }
}
template <int D> DI void softmax_tile(f32x16& p0, f32x16& p1, float& m_reg, float& l_reg, float& alpha, bf16x8& pa0, bf16x8& pa1, bf16x8& pa2, bf16x8& pa3, bool rowok) {
    constexpr float SCALE = (D == 64) ? 0.125f : 0.088388347648318440f;
    constexpr float C = SCALE * 1.4426950408889634f, THRR = 8.f / SCALE;
    float pmax = p0[0];
#pragma unroll
    for (int r = 1; r < 16; ++r) pmax = fmaxf(pmax, p0[r]);
#pragma unroll
    for (int r = 0; r < 16; ++r) pmax = fmaxf(pmax, p1[r]);
    { auto rr = __builtin_amdgcn_permlane32_swap(__float_as_uint(pmax), __float_as_uint(pmax), false, false);
      pmax = fmaxf(__uint_as_float(rr[0]), __uint_as_float(rr[1])); }
    if (!rowok) pmax = NEGS;
    float mn;
    if (__builtin_expect(__all(pmax - m_reg <= THRR), 1)) { mn = m_reg; alpha = 1.f; }
    else { mn = fmaxf(m_reg, pmax); alpha = fast_exp2((m_reg - mn) * C); m_reg = mn; }
    const float mnC = rowok ? -mn * C : -__builtin_inff();
#pragma unroll
    for (int r = 0; r < 16; ++r) { p0[r] = fast_exp2(fmaf(p0[r], C, mnC)); p1[r] = fast_exp2(fmaf(p1[r], C, mnC)); }
    float ps = 0.f;
#pragma unroll
    for (int r = 0; r < 16; ++r) ps += p0[r];
#pragma unroll
    for (int r = 0; r < 16; ++r) ps += p1[r];
    { auto rr = __builtin_amdgcn_permlane32_swap(__float_as_uint(ps), __float_as_uint(ps), false, false);
      ps = __uint_as_float(rr[0]) + __uint_as_float(rr[1]); }
    l_reg = l_reg * alpha + ps;
#define PK4(P, BASE, OUT) do { unsigned a0 = cvtpk(P[BASE + 0], P[BASE + 1]), a1 = cvtpk(P[BASE + 2], P[BASE + 3]);   \
    unsigned b0 = cvtpk(P[BASE + 4], P[BASE + 5]), b1 = cvtpk(P[BASE + 6], P[BASE + 7]);                              \
    auto r0 = __builtin_amdgcn_permlane32_swap(a0, b0, false, false); auto r1 = __builtin_amdgcn_permlane32_swap(a1, b1, false, false); \
    u32x4 w = {r0[0], r1[0], r0[1], r1[1]}; OUT = *reinterpret_cast<bf16x8*>(&w); } while (0)
    PK4(p0, 0, pa0); PK4(p0, 8, pa1); PK4(p1, 0, pa2); PK4(p1, 8, pa3);
#undef PK4
}
template <int D, int D0> DI void pv_one(f32x16& od, int vb, bf16x8 pa0, bf16x8 pa1, bf16x8 pa2, bf16x8 pa3) {
    const s16x4 l0 = tr_read<v_rd_off<D>(D0, 0, 0)>(vb), h0 = tr_read<v_rd_off<D>(D0, 0, 1)>(vb), l1 = tr_read<v_rd_off<D>(D0, 1, 0)>(vb), h1 = tr_read<v_rd_off<D>(D0, 1, 1)>(vb);
    const s16x4 l2 = tr_read<v_rd_off<D>(D0, 2, 0)>(vb), h2 = tr_read<v_rd_off<D>(D0, 2, 1)>(vb), l3 = tr_read<v_rd_off<D>(D0, 3, 0)>(vb), h3 = tr_read<v_rd_off<D>(D0, 3, 1)>(vb);
    asm volatile("s_waitcnt lgkmcnt(0)" ::: "memory"); SBAR();
#define PK(L, H) (bf16x8){L[0], L[1], L[2], L[3], H[0], H[1], H[2], H[3]}
    od = __builtin_amdgcn_mfma_f32_32x32x16_bf16(pa0, PK(l0, h0), od, 0, 0, 0);
    od = __builtin_amdgcn_mfma_f32_32x32x16_bf16(pa1, PK(l1, h1), od, 0, 0, 0);
    od = __builtin_amdgcn_mfma_f32_32x32x16_bf16(pa2, PK(l2, h2), od, 0, 0, 0);
    od = __builtin_amdgcn_mfma_f32_32x32x16_bf16(pa3, PK(l3, h3), od, 0, 0, 0);
#undef PK
}
template <int D> DI void pv_all(f32x16* o, int vb, bf16x8 pa0, bf16x8 pa1, bf16x8 pa2, bf16x8 pa3) {
    pv_one<D, 0>(o[0], vb, pa0, pa1, pa2, pa3); pv_one<D, 1>(o[1], vb, pa0, pa1, pa2, pa3);
    if constexpr (D == 128) { pv_one<D, 2>(o[2], vb, pa0, pa1, pa2, pa3); pv_one<D, 3>(o[3], vb, pa0, pa1, pa2, pa3); }
}
template <int D> struct StgH { bf16x8 x[D / 64]; };
template <int D> DI void stg_ld(StgH<D>& s, const bf16_t* g, int pitch, int tid) {
    if constexpr (D == 128) { const int sr = tid >> 4, sc = (tid & 15) * 8;
        s.x[0] = *(const GAS bf16x8*)(g + (size_t)sr * pitch + sc); s.x[1] = *(const GAS bf16x8*)(g + (size_t)(sr + 32) * pitch + sc);
    } else { const int sr = tid >> 3, sc = (tid & 7) * 8; s.x[0] = *(const GAS bf16x8*)(g + (size_t)sr * pitch + sc); }
}
template <int D> DI void stg_wrK(const StgH<D>& s, char* Kl, int tid) {
    if constexpr (D == 128) { const int sr = tid >> 4, sc = (tid & 15) * 8; *(bf16x8*)(Kl + koff<D>(sr, sc * 2)) = s.x[0]; *(bf16x8*)(Kl + koff<D>(sr + 32, sc * 2)) = s.x[1]; }
    else { const int sr = tid >> 3, sc = (tid & 7) * 8; *(bf16x8*)(Kl + koff<D>(sr, sc * 2)) = s.x[0]; }
}
template <int D> DI void stg_wrV(const StgH<D>& s, char* Vl, int tid) {
    if constexpr (D == 128) { const int sr = tid >> 4, sc = (tid & 15) * 8; *(bf16x8*)(Vl + v_st<D>(sr, sc)) = s.x[0]; *(bf16x8*)(Vl + v_st<D>(sr + 32, sc)) = s.x[1]; }
    else { const int sr = tid >> 3, sc = (tid & 7) * 8; *(bf16x8*)(Vl + v_st<D>(sr, sc)) = s.x[0]; }
}
#define LBAR() asm volatile("s_waitcnt lgkmcnt(0)\n\ts_barrier" ::: "memory")
template <int D, class MaskF>
DI void tile_finish(Core<D>& c, f32x16& p0, f32x16& p1, int j, const MaskF& mk, float* ws, int vb, int r32, int hi) {
    if (mk.partial(j)) { const int kb = 64 * j;
#pragma unroll
        for (int r = 0; r < 16; ++r) { const int k0 = kb + crow(r, hi); if (!mk.ok(j, k0)) p0[r] = NEGS; if (!mk.ok(j, k0 + 32)) p1[r] = NEGS; } }
    float alpha; bf16x8 pa0, pa1, pa2, pa3;
    softmax_tile<D>(p0, p1, c.m_reg, c.l_reg, alpha, pa0, pa1, pa2, pa3, mk.rowok(j));
    if (__any(alpha < 1.f)) { if (hi == 0) ws[32 + r32] = alpha; LDS_WAIT();
#pragma unroll
        for (int r = 0; r < 16; ++r) { const float a = ws[32 + crow(r, hi)];
#pragma unroll
            for (int d = 0; d < D / 32; ++d) c.o[d][r] *= a; } }
    SBAR();
    pv_all<D>(c.o, vb, pa0, pa1, pa2, pa3);
}
template <int D, bool PIPE, class Seq, class MaskF, class KX>
DI void run_tiles(Core<D>& c, char* kv, float* ws, const bf16_t* Kg0, const bf16_t* Vg0, int pitch, const Seq& seq, const MaskF& mk, const KX& kx, int tid_, int lane_) {
    constexpr int KB = 64 * D * 2;
    int tid = tid_, lane = lane_; asm volatile("" : "+v"(tid), "+v"(lane));
    const int r32 = lane & 31, hi = lane >> 5;
    int t0; if (!seq.first(t0)) return;
    const int vb0 = (int)(uintptr_t)(kv + 2 * KB) + v_rd_base(lane);
    StgH<D> sk, sv;
    if constexpr (!PIPE) {
        stg_ld<D>(sk, Kg0 + (size_t)64 * t0 * pitch, pitch, tid); stg_ld<D>(sv, Vg0 + (size_t)64 * t0 * pitch, pitch, tid);
        LBAR();
        kx.apply(sk, t0, tid); stg_wrK<D>(sk, kv, tid); stg_wrV<D>(sv, kv + 2 * KB, tid);
        LBAR();
        int buf = 0;
        for (;;) {
            int t1 = 0; const bool e1 = seq.next(t0, t1);
            if (e1) { stg_ld<D>(sk, Kg0 + (size_t)64 * t1 * pitch, pitch, tid); stg_ld<D>(sv, Vg0 + (size_t)64 * t1 * pitch, pitch, tid); }
            f32x16 p0, p1; qkt<D>(p0, p1, kv + buf * KB, c.qr, r32, hi);
            tile_finish<D>(c, p0, p1, t0, mk, ws, vb0 + buf * KB, r32, hi);
            if (e1) { kx.apply(sk, t1, tid); stg_wrK<D>(sk, kv + (buf ^ 1) * KB, tid); stg_wrV<D>(sv, kv + 2 * KB + (buf ^ 1) * KB, tid); }
            LBAR();
            if (!e1) break;
            t0 = t1; buf ^= 1;
        }
    } else {
    int t1 = 0, t2 = 0, t3 = 0;
    bool e1 = seq.next(t0, t1), e2 = e1 && seq.next(t1, t2), e3 = e2 && seq.next(t2, t3);
    stg_ld<D>(sk, Kg0 + (size_t)64 * t0 * pitch, pitch, tid); stg_ld<D>(sv, Vg0 + (size_t)64 * t0 * pitch, pitch, tid);
    LBAR();
    kx.apply(sk, t0, tid); stg_wrK<D>(sk, kv, tid); stg_wrV<D>(sv, kv + 2 * KB, tid);
    if (e1) { stg_ld<D>(sk, Kg0 + (size_t)64 * t1 * pitch, pitch, tid); kx.apply(sk, t1, tid); stg_wrK<D>(sk, kv + KB, tid); }
    LBAR();
    f32x16 pA0, pA1, pB0, pB1;
    qkt<D>(pA0, pA1, kv, c.qr, r32, hi);
    if (e2) stg_ld<D>(sk, Kg0 + (size_t)64 * t2 * pitch, pitch, tid);
    if (e1) stg_ld<D>(sv, Vg0 + (size_t)64 * t1 * pitch, pitch, tid);
    LBAR();
#define ATT_STEP(P0, P1, Q0, Q1, PAR) do { \
        if (e2) { kx.apply(sk, t2, tid); stg_wrK<D>(sk, kv + (PAR) * KB, tid); } \
        if (e1) stg_wrV<D>(sv, kv + 2 * KB + ((PAR) ^ 1) * KB, tid); \
        if (e3) stg_ld<D>(sk, Kg0 + (size_t)64 * t3 * pitch, pitch, tid); \
        if (e2) stg_ld<D>(sv, Vg0 + (size_t)64 * t2 * pitch, pitch, tid); \
        if (e1) qkt<D>(Q0, Q1, kv + ((PAR) ^ 1) * KB, c.qr, r32, hi); \
        tile_finish<D>(c, P0, P1, t0, mk, ws, vb0 + (PAR) * KB, r32, hi); \
        LBAR(); \
    } while (0)
    for (;;) {
        ATT_STEP(pA0, pA1, pB0, pB1, 0);
        if (!e1) break;
        t0 = t1; t1 = t2; t2 = t3; e1 = e2; e2 = e3; e3 = e2 && seq.next(t2, t3);
        ATT_STEP(pB0, pB1, pA0, pA1, 1);
        if (!e1) break;
        t0 = t1; t1 = t2; t2 = t3; e1 = e2; e2 = e3; e3 = e2 && seq.next(t2, t3);
    }
#undef ATT_STEP
    }
}
#undef SBAR
}

struct Args { const float* in[24]; float* out; unsigned char* ws; };
template <int OFF> DI unsigned long long karg_u64() {
    unsigned long long v; auto kp = __builtin_amdgcn_kernarg_segment_ptr();
    asm volatile("s_load_dwordx2 %0, %1, %2\n\ts_waitcnt lgkmcnt(0)" : "=s"(v) : "s"(kp), "n"(OFF));
    return v;
}
template <int I> DI const float* arg_in() { return (const float*)karg_u64<8 * I>(); }
DI float* arg_out() { return (float*)karg_u64<192>(); }
DI unsigned char* arg_ws() { return (unsigned char*)karg_u64<200>(); }

DI float wave_sum(float v) {
#pragma unroll
    for (int o = 1; o < 64; o <<= 1) v += __shfl_xor(v, o);
    return v;
}
struct TJob { const float* src; const float* gain; bf16_t* dst; int K, pitch, nsrc, ndst, mode, coff; };
DI void get_job(int j, TJob& J) {
    unsigned char* ws = arg_ws(); J.gain = nullptr; J.mode = 0; J.coff = 0;
    if (j < 16) { const int L = j >> 2, k = j & 3, w = k >> 1;
        if ((k & 1) == 0) { J.src = (w ? arg_in<7>() : arg_in<3>()) + (size_t)L * DM * NFF; J.gain = (w ? arg_in<6>() : arg_in<2>()) + (size_t)L * DM; J.dst = (bf16_t*)(ws + WS_WFI + (size_t)(L * 2 + w) * SZ_WFI);
            J.K = DM; J.pitch = NFF; J.nsrc = NFF; J.ndst = NFF; J.mode = 1; }
        else { J.src = (w ? arg_in<8>() : arg_in<4>()) + (size_t)L * DFF * DM; J.dst = (bf16_t*)(ws + WS_WFO + (size_t)(L * 2 + w) * SZ_WFO); J.K = DFF; J.pitch = DM; J.nsrc = DM; J.ndst = DM; }
    } else if (j < 24) { const int jj = j - 16, L2 = jj >> 2, k = jj & 3;
        if (k == 0) { J.src = arg_in<9>() + (size_t)L2 * DM * SW_N; J.gain = arg_in<5>() + (size_t)(2 * L2) * DM; J.dst = (bf16_t*)(ws + WS_WSI + (size_t)L2 * SZ_WSI); J.K = DM; J.pitch = SW_N; J.nsrc = SW_N; J.ndst = SW_N; }
        else if (k == 1) { J.src = arg_in<13>() + (size_t)L2 * DM * DM; J.dst = (bf16_t*)(ws + WS_WSO + (size_t)L2 * SZ_WO); J.K = DM; J.pitch = DM; J.nsrc = DM; J.ndst = DM; }
        else if (k == 2) { J.src = arg_in<14>() + (size_t)L2 * DM * NS_NREAL; J.gain = arg_in<5>() + (size_t)(2 * L2 + 1) * DM; J.dst = (bf16_t*)(ws + WS_WNI + (size_t)L2 * SZ_WNI); J.K = DM; J.pitch = NS_NREAL; J.nsrc = NS_N; J.ndst = NS_N; }
        else { J.src = arg_in<23>() + (size_t)L2 * DM * DM; J.dst = (bf16_t*)(ws + WS_WNO + (size_t)L2 * SZ_WO); J.K = DM; J.pitch = DM; J.nsrc = DM; J.ndst = DM; }
    } else if (j >= 32) { const int L2 = j - 32;
        J.src = arg_in<14>() + (size_t)L2 * DM * NS_NREAL; J.gain = arg_in<5>() + (size_t)(2 * L2 + 1) * DM; J.dst = (bf16_t*)(ws + WS_WG + (size_t)L2 * SZ_WG); J.K = DM; J.pitch = NS_NREAL; J.nsrc = 48; J.ndst = 64; J.coff = NS_N;
    } else { const int jj = j - 24, L2 = jj >> 2, k = jj & 3;
        if (k < 2) { J.src = (k == 0 ? arg_in<18>() : arg_in<21>()) + (size_t)L2 * 4096 * 256; J.dst = (bf16_t*)(ws + WS_W1 + (size_t)(L2 * 2 + k) * SZ_W1); J.K = 4096; J.pitch = 256; J.nsrc = 256; J.ndst = 256; J.mode = 2; }
        else { J.src = (k == 2 ? arg_in<19>() : arg_in<22>()) + (size_t)L2 * 256 * 128; J.dst = (bf16_t*)(ws + WS_W2 + (size_t)(L2 * 2 + (k - 2)) * SZ_W2); J.K = 256; J.pitch = 128; J.nsrc = 128; J.ndst = 128; }
    }
}
DI void transpose_item(const TJob& J, LAS float* scr, int item, int lane) {
    const int nblk = J.ndst / 64, kb = item / nblk, nb = item % nblk, k0 = 64 * kb, n0 = 64 * nb;
    int sc0 = n0; if (J.mode == 1) sc0 = ((n0 & 255) >> 7) * DFF + (n0 >> 8) * 128 + (n0 & 127);
    const int ln = lane & 15, kr = lane >> 4;
    const int col = J.coff + sc0 + 4 * ln; const bool okc = (n0 + 4 * ln) < J.nsrc;
    f32x4 v[16];
#pragma unroll
    for (int i = 0; i < 16; ++i) v[i] = okc ? __builtin_nontemporal_load((const GAS f32x4*)(J.src + (size_t)(k0 + 4 * i + kr) * J.pitch + col)) : (f32x4){0.f, 0.f, 0.f, 0.f};
#pragma unroll
    for (int i = 0; i < 16; ++i) { LAS float* d = scr + (4 * i + kr) * 65 + 4 * ln; d[0] = v[i][0]; d[1] = v[i][1]; d[2] = v[i][2]; d[3] = v[i][3]; }
    const int c = lane & 7;
    f32x4 ga = {1.f, 1.f, 1.f, 1.f}, gb = {1.f, 1.f, 1.f, 1.f};
    if (J.gain) { ga = *(const GAS f32x4*)(J.gain + k0 + 8 * c); gb = *(const GAS f32x4*)(J.gain + k0 + 8 * c + 4); }
    LDS_WAIT(); asm volatile("" ::: "memory");
#pragma unroll
    for (int jx = 0; jx < 8; ++jx) { const int n = (lane >> 3) + 8 * jx; const LAS float* s = scr + (8 * c) * 65 + n;
        u32x4 o; o.x = cvtpk(s[0 * 65] * ga[0], s[1 * 65] * ga[1]); o.y = cvtpk(s[2 * 65] * ga[2], s[3 * 65] * ga[3]); o.z = cvtpk(s[4 * 65] * gb[0], s[5 * 65] * gb[1]); o.w = cvtpk(s[6 * 65] * gb[2], s[7 * 65] * gb[3]);
        const int nn = n0 + n, k8 = (k0 >> 3) + c;
        const size_t di = J.mode == 2 ? ((size_t)((nn >> 5) * (J.K >> 4) + (k8 >> 1)) * 64 + (nn & 31) + 32 * (k8 & 1)) * 8
                                       : (size_t)nn * J.K + k0 + 8 * c;
        *(GAS u32x4*)(J.dst + di) = o; }
    LDS_WAIT(); asm volatile("" ::: "memory");
}
constexpr int NJOBS_PRO = 30;
__device__ const unsigned char JOB_ORDER[NJOBS_PRO] = {12,13,14,15,22,23,28,29,30,31,33,8,9,10,20,4,5,6,7,18,19,24,25,26,27,32,16,2,1,0};
DI void prologue(LAS unsigned char* lds, int vcu, int G, int wave, int lane) {
    unsigned char* const wsb = arg_ws();
    LAS float* scr = (LAS float*)(lds + wave * 16640);
    const int gw = vcu * NWAVES + wave, NGW = G * NWAVES;
    {
        const int* pos = (const int*)arg_in<1>();
        float* t64 = (float*)(wsb + WS_ROPE64); float* t128 = (float*)(wsb + WS_ROPE128);
        const int i = lane < 8 ? lane : lane - 8;
        const double ex = lane < 8 ? (double)i / 8.0 : (double)i / 16.0;
        const float inv = (float)(1.0 / exp2(ex * 18.931568569324174));
        for (int m = gw; m < M; m += NGW) {
            if (lane < 24) {
                const float ang = (float)((const GAS int*)pos)[m] * inv;
                double rev = (double)ang * 0.15915494309189535; rev -= floor(rev);
                const float fr = (float)rev;
                const float sn = __builtin_amdgcn_sinf(fr), cs = __builtin_amdgcn_cosf(fr);
                if (lane < 8) { ((GAS float*)t64)[(size_t)m * 16 + i] = cs; ((GAS float*)t64)[(size_t)m * 16 + 8 + i] = sn; }
                else { ((GAS float*)t128)[(size_t)m * 32 + i] = cs; ((GAS float*)t128)[(size_t)m * 32 + 16 + i] = sn; }
            }
        }
    }
    {
        const float* x = arg_in<0>(); bf16_t* hb = (bf16_t*)(wsb + WS_HB); bf16_t* lb = (bf16_t*)(wsb + WS_LB); float* rowss = (float*)(wsb + WS_ROWSS);
        for (int m = gw; m < M; m += NGW) {
            const GAS f32x4* xr = (const GAS f32x4*)(x + (size_t)m * DM) + lane; float s = 0.f;
            GAS u32x2* l8 = (GAS u32x2*)(lb + (size_t)m * DM) + lane;
#pragma unroll
            for (int jx = 0; jx < 8; ++jx) { const f32x4 v = xr[64 * jx]; s += (v[0] * v[0] + v[1] * v[1]) + (v[2] * v[2] + v[3] * v[3]);
                u32x2 w; w.x = cvtpk(v[0], v[1]); w.y = cvtpk(v[2], v[3]);
                { const int c = (jx * 64 + lane) * 4; *(GAS u32x2*)(hb + (size_t)(c >> 8) * ((size_t)M * 256) + (size_t)m * 256 + (c & 255)) = w; }
                if (RES_LO) { u32x2 wl; wl.x = cvtpk(v[0] - bflo(w.x), v[1] - bfhi(w.x)); wl.y = cvtpk(v[2] - bflo(w.y), v[3] - bfhi(w.y)); l8[64 * jx] = wl; } }
            s = wave_sum(s);
            if (lane < 32) ((GAS float*)rowss)[(size_t)lane * M + m] = lane == 0 ? s : 0.f;
        }
    }
    {
        for (int tk = gw; tk < 128; tk += NGW) { const int L2 = tk >> 6, kvi = (tk >> 5) & 1, l = tk & 31;
            const float* pe = (kvi ? arg_in<20>() : arg_in<17>()) + (size_t)L2 * 32 * 128 + l * 128;
            const float* w1 = (kvi ? arg_in<21>() : arg_in<18>()) + (size_t)L2 * 4096 * 256 + (size_t)l * 128 * 256;
            f32x4 acc = {0.f, 0.f, 0.f, 0.f};
            for (int d = 0; d < 128; ++d) { const float p = ((const GAS float*)pe)[d]; const f32x4 w = ((const GAS f32x4*)(w1 + (size_t)d * 256))[lane]; acc += w * p; }
            ((GAS f32x4*)(wsb + WS_BIASP + (size_t)(L2 * 2 + kvi) * SZ_BIASP + (size_t)l * 256 * 4))[lane] = acc;
        }
    }
    int off = gw;
    for (int jo = 0; jo < NJOBS_PRO; ++jo) {
        const int j = (int)JOB_ORDER[jo];
        TJob J; get_job(j, J);
        const int nitems = (J.K / 64) * (J.ndst / 64);
        int it = off;
        for (; it < nitems; it += NGW) transpose_item(J, scr, it, lane);
        off = it - nitems;
    }
}

DI void convert_deferred(LAS unsigned char* lds, int L2, int idx, int NIDLE, int wave, int lane) {
    LAS float* scr = (LAS float*)(lds + wave * 16640);
    const int gw = idx * NWAVES + wave, NGW = NIDLE * NWAVES;
    int off = gw;
#pragma unroll 1
    for (int q = 0; q < 2; ++q) {
        const int j = q == 0 ? 17 + 4 * L2 : 3 + 8 * L2;
        TJob J; get_job(j, J);
        const int nitems = (J.K / 64) * (J.ndst / 64);
        int it = off;
        for (; it < nitems; it += NGW) transpose_item(J, scr, it, lane);
        off = it - nitems;
    }
}

template <int CTRL> DI float dppf(float v) { return __builtin_bit_cast(float, __builtin_amdgcn_update_dpp(0, __builtin_bit_cast(int, v), CTRL, 0xF, 0xF, false)); }
template <int LPR> DI float row_sum(float ss) {
    ss += dppf<0xB1>(ss); ss += dppf<0x4E>(ss); ss += dppf<0x141>(ss);
    if constexpr (LPR == 16) ss += dppf<0x140>(ss);
    return ss;
}
template <int HD> DI void norm_rope8(float (&x)[8], const float* gain, const float* tab  , int sub) {
    constexpr int LPR = HD / 8, HALFR = HD / 8;
    float ss = 0.f;
#pragma unroll
    for (int e = 0; e < 8; ++e) ss += x[e] * x[e];
    if constexpr (HD == 64) ss = row_sum<LPR>(ss); else {
#pragma unroll
    for (int o = 1; o < LPR; o <<= 1) ss += __shfl_xor(ss, o); }
    const float rs = rsqrtf(ss * (1.0f / HD) + EPS);
#pragma unroll
    for (int e = 0; e < 8; ++e) x[e] = x[e] * rs * ((const GAS float*)gain)[sub * 8 + e];
    constexpr int XL = HALFR / 8;
    float y[8];
#pragma unroll
    for (int e = 0; e < 8; ++e) { if constexpr (HD == 64) y[e] = dppf<XL == 1 ? 0xB1 : 0x4E>(x[e]); else y[e] = __shfl_xor(x[e], XL); }
    if (sub < 2 * XL) {
        const bool first = sub < XL; const int i0 = (sub & (XL - 1)) * 8;
#pragma unroll
        for (int e = 0; e < 8; ++e) { const float cs = ((const GAS float*)tab)[i0 + e], sn = ((const GAS float*)tab)[HALFR + i0 + e];
            x[e] = first ? (x[e] * cs - y[e] * sn) : (x[e] * cs + y[e] * sn); }
    }
}
template <int D> DI void qnorm_rope(att::Core<D>& c, const float* gain, const float* tab, int hi) {
    constexpr int ND = D / 16, HALFR = D / 8;
    float x[ND][8]; float ss = 0.f;
#pragma unroll
    for (int d0 = 0; d0 < ND; ++d0) { const u32x4 w = __builtin_bit_cast(u32x4, c.qr[d0]);
        x[d0][0] = bflo(w.x); x[d0][1] = bfhi(w.x); x[d0][2] = bflo(w.y); x[d0][3] = bfhi(w.y); x[d0][4] = bflo(w.z); x[d0][5] = bfhi(w.z); x[d0][6] = bflo(w.w); x[d0][7] = bfhi(w.w);
#pragma unroll
        for (int e = 0; e < 8; ++e) ss += x[d0][e] * x[d0][e]; }
    ss = sum_xor32(ss);
    const float rs = __builtin_amdgcn_rsqf(ss * (1.0f / D) + EPS);
#pragma unroll
    for (int d0 = 0; d0 < ND; ++d0) { const f32x4 ga = *(const GAS f32x4*)(gain + d0 * 16 + hi * 8), gb = *(const GAS f32x4*)(gain + d0 * 16 + hi * 8 + 4);
#pragma unroll
        for (int e = 0; e < 8; ++e) x[d0][e] = x[d0][e] * rs * (e < 4 ? ga[e] : gb[e - 4]); }
    if constexpr (D == 64) {
        const f32x4 ca = *(const GAS f32x4*)(tab), cb = *(const GAS f32x4*)(tab + 4), sa = *(const GAS f32x4*)(tab + HALFR), sb = *(const GAS f32x4*)(tab + HALFR + 4);
#pragma unroll
        for (int e = 0; e < 8; ++e) { const float cs = e < 4 ? ca[e] : cb[e - 4], sn = e < 4 ? sa[e] : sb[e - 4];
            auto rr = __builtin_amdgcn_permlane32_swap(__float_as_uint(x[0][e]), __float_as_uint(x[0][e]), false, false);
            const float y = __uint_as_float(hi ? rr[0] : rr[1]);
            x[0][e] = hi ? (x[0][e] * cs + y * sn) : (x[0][e] * cs - y * sn); }
    } else {
        const f32x4 ca = *(const GAS f32x4*)(tab + hi * 8), cb = *(const GAS f32x4*)(tab + hi * 8 + 4), sa = *(const GAS f32x4*)(tab + HALFR + hi * 8), sb = *(const GAS f32x4*)(tab + HALFR + hi * 8 + 4);
#pragma unroll
        for (int e = 0; e < 8; ++e) { const float cs = e < 4 ? ca[e] : cb[e - 4], sn = e < 4 ? sa[e] : sb[e - 4];
            const float x1 = x[0][e], x2 = x[1][e]; x[0][e] = x1 * cs - x2 * sn; x[1][e] = x2 * cs + x1 * sn; }
    }
#pragma unroll
    for (int d0 = 0; d0 < ND; ++d0) { u32x4 w; w.x = cvtpk(x[d0][0], x[d0][1]); w.y = cvtpk(x[d0][2], x[d0][3]); w.z = cvtpk(x[d0][4], x[d0][5]); w.w = cvtpk(x[d0][6], x[d0][7]); c.qr[d0] = __builtin_bit_cast(bf16x8, w); }
}
struct KxNone { DI void apply(att::StgH<64>&, int, int) const {} DI void apply(att::StgH<128>&, int, int) const {} };
struct KxNorm64 { const float* gain; const float* tab;
    DI void apply(att::StgH<64>& s, int tile, int tid) const {
        const int sr = tid >> 3, sub = tid & 7; const u32x4 w = __builtin_bit_cast(u32x4, s.x[0]); float x[8];
        x[0] = bflo(w.x); x[1] = bfhi(w.x); x[2] = bflo(w.y); x[3] = bfhi(w.y); x[4] = bflo(w.z); x[5] = bfhi(w.z); x[6] = bflo(w.w); x[7] = bfhi(w.w);
        norm_rope8<64>(x, gain, tab + (size_t)(64 * tile + sr) * 16, sub);
        u32x4 o; o.x = cvtpk(x[0], x[1]); o.y = cvtpk(x[2], x[3]); o.z = cvtpk(x[4], x[5]); o.w = cvtpk(x[6], x[7]); s.x[0] = __builtin_bit_cast(bf16x8, o); }
    DI void apply(att::StgH<128>&, int, int) const {} };
DI void ld8(const bf16_t* p, float (&x)[8]) { const u32x4 w = *(const GAS u32x4*)p; x[0] = bflo(w.x); x[1] = bfhi(w.x); x[2] = bflo(w.y); x[3] = bfhi(w.y); x[4] = bflo(w.z); x[5] = bfhi(w.z); x[6] = bflo(w.w); x[7] = bfhi(w.w); }
DI void st8(bf16_t* p, const float (&x)[8]) { u32x4 w; w.x = cvtpk(x[0], x[1]); w.y = cvtpk(x[2], x[3]); w.z = cvtpk(x[4], x[5]); w.w = cvtpk(x[6], x[7]); *(GAS u32x4*)p = w; }

DI void nsa_normrope(int L2, int gw, int NGW, int lane) {
    unsigned char* const wsb = arg_ws();
    bf16_t* qkv = (bf16_t*)(wsb + WS_ACT); const float* tab = (const float*)(wsb + WS_ROPE128);
    const float* kg = arg_in<16>() + L2 * 128;
    const int grp = lane >> 4, sub = lane & 15;
    float gn[8];
#pragma unroll
    for (int e = 0; e < 8; ++e) gn[e] = ((const GAS float*)kg)[sub * 8 + e];
    const bool roper = sub < 4, first = sub < 2; const int i0 = (sub & 1) * 8;
    const long nrows = (long)M * 8, stride = (long)NGW * 4;
    for (long hr0 = (long)gw * 4 + grp; hr0 < nrows; hr0 += stride * 4) {
        u32x4 w[4]; f32x4 ca[4], cb[4], sa[4], sb[4]; bf16_t* p[4]; bool ok[4];
#pragma unroll
        for (int u = 0; u < 4; ++u) { const long hr = hr0 + u * stride; ok[u] = hr < nrows; const long hq = ok[u] ? hr : hr0;
            const int m = (int)(hq >> 3), j = (int)(hq & 7); const int col = j < 4 ? NS_KS + j * 128 : NS_KW + (j - 4) * 128;
            p[u] = qkv + (size_t)m * NS_N + col + sub * 8; w[u] = *(const GAS u32x4*)p[u];
            const float* t = tab + (size_t)m * 32 + i0;
            ca[u] = *(const GAS f32x4*)t; cb[u] = *(const GAS f32x4*)(t + 4); sa[u] = *(const GAS f32x4*)(t + 16); sb[u] = *(const GAS f32x4*)(t + 20); }
#pragma unroll
        for (int u = 0; u < 4; ++u) {
            float x[8]; x[0] = bflo(w[u].x); x[1] = bfhi(w[u].x); x[2] = bflo(w[u].y); x[3] = bfhi(w[u].y); x[4] = bflo(w[u].z); x[5] = bfhi(w[u].z); x[6] = bflo(w[u].w); x[7] = bfhi(w[u].w);
            float ss = 0.f;
#pragma unroll
            for (int e = 0; e < 8; ++e) ss += x[e] * x[e];
            ss = row_sum<16>(ss);
            const float rs = rsqrtf(ss * (1.0f / 128) + EPS);
#pragma unroll
            for (int e = 0; e < 8; ++e) x[e] = x[e] * rs * gn[e];
            float y[8];
#pragma unroll
            for (int e = 0; e < 8; ++e) y[e] = dppf<0x4E>(x[e]);
            if (roper) {
#pragma unroll
                for (int e = 0; e < 8; ++e) { const float cs = e < 4 ? ca[u][e] : cb[u][e - 4], sn = e < 4 ? sa[u][e] : sb[u][e - 4];
                    x[e] = first ? (x[e] * cs - y[e] * sn) : (x[e] * cs + y[e] * sn); }
            }
            if (ok[u]) st8(p[u], x);
        }
    }
}

struct SeqRange { int lo, hi; DI bool first(int& j) const { j = lo; return lo <= hi; } DI bool next(int j, int& jn) const { jn = j + 1; return jn <= hi; } };
struct MaskWin { int t, w, tmin, tmax;
    DI bool ok(int, int key) const { return key <= t && key > t - w; }
    DI bool partial(int j) const { return !(64 * j + 63 <= tmin && 64 * j > tmax - w); }
    DI bool rowok(int) const { return true; } };
DI void swa_attention(int L2, char* lds, int vcu, int G, int tid, int wave, int lane) {
#define SWA_QKV ((const bf16_t*)(arg_ws() + WS_ACT))
#define SWA_RTAB ((const float*)(arg_ws() + WS_ROPE64))
    const int r32 = lane & 31, hi = lane >> 5;
    constexpr int KB = 8192, BUFB = 49152;
    float* ws = (float*)(lds + 98304) + wave * 64;
    bf16_t* stg = (bf16_t*)(lds + 98304 + 2048) + wave * 2048;
    constexpr int NU = NB * 4 * (T / 64);
    const int per = (NU + G - 1) / G;
    att::StgH<64> sk0, sk1, sk2;
#define SWA_TILES_LD(u_) do { const int bg_ = (u_) / (T / 64), q_ = (u_) % (T / 64), jl_ = q_ - 2 < 0 ? 0 : q_ - 2, n_ = q_ - jl_ + 1; \
        const bf16_t* Kg_ = SWA_QKV + (size_t)(bg_ >> 2) * T * SW_N + 2048 + (bg_ & 3) * 64 + (size_t)64 * jl_ * SW_N; \
        att::stg_ld<64>(sk0, Kg_, SW_N, tid); \
        if (n_ > 1) att::stg_ld<64>(sk1, Kg_ + (size_t)64 * SW_N, SW_N, tid); \
        if (n_ > 2) att::stg_ld<64>(sk2, Kg_ + (size_t)128 * SW_N, SW_N, tid); } while (0)
    if (vcu * per < NU) SWA_TILES_LD(vcu * per);
    for (int ui = 0; ui < per; ++ui) {
        const int u = vcu * per + ui; if (u >= NU) break;
        const int bg = u / (T / 64), q64 = u % (T / 64), b = bg >> 2, g = bg & 3;
        const int t0 = q64 * 64, h = 8 * g + wave, jlo = q64 - 2 < 0 ? 0 : q64 - 2, ntl = q64 - jlo + 1;
        char* const Kl = lds + (ui & 1) * BUFB; char* const Vl = Kl + 3 * KB;
        {
            KxNorm64 kx; kx.gain = arg_in<11>() + L2 * 64; kx.tab = SWA_RTAB + (size_t)b * T * 16;
            att::StgH<64> sv0, sv1, sv2;
            const bf16_t* Vg = SWA_QKV + (size_t)b * T * SW_N + 2304 + g * 64 + (size_t)64 * jlo * SW_N;
            att::stg_ld<64>(sv0, Vg, SW_N, tid); if (ntl > 1) att::stg_ld<64>(sv1, Vg + (size_t)64 * SW_N, SW_N, tid); if (ntl > 2) att::stg_ld<64>(sv2, Vg + (size_t)128 * SW_N, SW_N, tid);
            kx.apply(sk0, jlo, tid); att::stg_wrK<64>(sk0, Kl, tid);
            if (ntl > 1) { kx.apply(sk1, jlo + 1, tid); att::stg_wrK<64>(sk1, Kl + KB, tid); }
            if (ntl > 2) { kx.apply(sk2, jlo + 2, tid); att::stg_wrK<64>(sk2, Kl + 2 * KB, tid); }
            att::stg_wrV<64>(sv0, Vl, tid); if (ntl > 1) att::stg_wrV<64>(sv1, Vl + KB, tid); if (ntl > 2) att::stg_wrV<64>(sv2, Vl + 2 * KB, tid);
        }
        __syncthreads();
        if (ui + 1 < per && u + 1 < NU) SWA_TILES_LD(u + 1);
        const int vb0 = (int)(uintptr_t)Vl + att::v_rd_base(lane);
        const float sink = ((const GAS float*)(arg_in<12>() + L2 * 32))[h];
#pragma unroll 1
        for (int hb = 0; hb < 2; ++hb) {
            const int tq0 = t0 + 32 * hb, t = tq0 + r32;
            att::Core<64> c;
            att::load_q<64>(c, SWA_QKV + (size_t)(b * T + t) * SW_N + h * 64, hi);
            qnorm_rope<64>(c, arg_in<10>() + L2 * 64, SWA_RTAB + (size_t)(b * T + t) * 16, hi);
            att::core_reset<64>(c, sink * 8.0f, 1.0f);
            MaskWin mk; mk.t = t; mk.w = 128; mk.tmin = tq0; mk.tmax = tq0 + 31;
#pragma unroll 1
            for (int sl = 0; sl < ntl; ++sl) {
                f32x16 p0, p1; att::qkt<64>(p0, p1, Kl + sl * KB, c.qr, r32, hi);
                att::tile_finish<64>(c, p0, p1, jlo + sl, mk, ws, vb0 + sl * KB, r32, hi);
            }
            if (hi == 0) ws[r32] = fast_rcp(c.l_reg);
            LDS_WAIT();
#pragma unroll
            for (int r = 0; r < 16; ++r) { const int orow = att::crow(r, hi); const float f = ws[orow];
#pragma unroll
                for (int d0 = 0; d0 < 2; ++d0) stg[orow * 64 + d0 * 32 + r32] = f2bf1(c.o[d0][r] * f); }
            LDS_WAIT();
#pragma unroll
            for (int i = 0; i < 4; ++i) { const int row = i * 8 + (lane >> 3), ch = lane & 7; const u32x4 v = *(const u32x4*)(stg + row * 64 + ch * 8);
                *(GAS u32x4*)((bf16_t*)(arg_ws() + WS_OB) + (size_t)(b * T + tq0 + row) * DM + h * 64 + ch * 8) = v; }
            LDS_WAIT();
        }
    }
#undef SWA_TILES_LD
    __syncthreads();
}

DI void nsa_compress(int L2, char* lds, int vcu, int G, int tid, int wave, int lane) {
    unsigned char* const wsb = arg_ws(); const float* const kgain = arg_in<16>() + L2 * 128;
    const bf16_t* qkv = (const bf16_t*)(wsb + WS_ACT);
    const int r32 = lane & 31, hi = lane >> 5;
    char* abuf = lds; bf16_t* hid = (bf16_t*)(lds + 65536); float* outf = (float*)(lds + 65536 + 17408);
    const int sn = tid >> 4, sc16 = tid & 15;
    for (int it = vcu; it < 256; it += G) {
        const int kvi = it >> 7, bg = (it >> 3) & 15, nt = it & 7, b = bg >> 2, g = bg & 3, n0 = nt * 32;
        const bf16_t* w1t = (const bf16_t*)(wsb + WS_W1 + (size_t)(L2 * 2 + kvi) * SZ_W1);
        const bf16_t* w2t = (const bf16_t*)(wsb + WS_W2 + (size_t)(L2 * 2 + kvi) * SZ_W2);
        const float* biasp = (const float*)(wsb + WS_BIASP + (size_t)(L2 * 2 + kvi) * SZ_BIASP);
        const int colb = (kvi ? NS_VC : NS_KC) + g * 128;
        f32x16 acc;
#pragma unroll
        for (int r = 0; r < 16; ++r) acc[r] = 0.f;
        const bf16_t* brow = w1t + ((size_t)wave * 256 * 64 + lane) * 8;
        bf16x8 areg[8];
#define CMP_ALOAD(ck) do { _Pragma("unroll") for (int i_ = 0; i_ < 8; ++i_) { int tok_ = 16 * (n0 + sn) + 8 * (ck) + i_; tok_ = tok_ > T - 1 ? T - 1 : tok_; \
            areg[i_] = *(const GAS bf16x8*)(qkv + (size_t)(b * T + tok_) * NS_N + colb + sc16 * 8); } } while (0)
#define CMP_BLOAD(dst, l2) do { _Pragma("unroll") for (int q_ = 0; q_ < 16; ++q_) dst[q_] = *(const GAS bf16x8*)(brow + (size_t)(16 * (l2) + q_) * 512); } while (0)
        CMP_ALOAD(0);
        bf16x8 bA[16], bB[16];
        CMP_BLOAD(bA, 0);
        __syncthreads();
        for (int ck = 0; ck < 4; ++ck) {
#pragma unroll
            for (int i = 0; i < 8; ++i) *(bf16x8*)(abuf + i * 8192 + att::koff<128>(sn, sc16 * 16)) = areg[i];
            __syncthreads();
            if (ck < 3) CMP_ALOAD(ck + 1);
#pragma unroll
            for (int p = 0; p < 4; ++p) {
                const int l2 = ck * 4 + p;
                if (p & 1) { if (l2 + 1 < 16) CMP_BLOAD(bA, l2 + 1); } else { CMP_BLOAD(bB, l2 + 1); }
#pragma unroll
                for (int q = 0; q < 16; ++q) {
                    const bf16x8 av = *(const bf16x8*)(abuf + (2 * p + (q >> 3)) * 8192 + att::koff<128>(r32, ((q & 7) * 16 + hi * 8) * 2));
                    acc = __builtin_amdgcn_mfma_f32_32x32x16_bf16(av, (p & 1) ? bB[q] : bA[q], acc, 0, 0, 0);
                }
            }
            __syncthreads();
        }
#undef CMP_ALOAD
#undef CMP_BLOAD
        float bias = 0.f;
        { float bl[32];
#pragma unroll
          for (int l = 0; l < 32; ++l) bl[l] = ((const GAS float*)biasp)[l * 256 + 32 * wave + r32];
#pragma unroll
          for (int l = 0; l < 32; ++l) bias += bl[l]; }
#pragma unroll
        for (int r = 0; r < 16; ++r) hid[att::crow(r, hi) * 264 + 32 * wave + r32] = f2bf1(silu(acc[r] + bias));
        __syncthreads();
        if (wave < 4) {
            f32x16 o2;
#pragma unroll
            for (int r = 0; r < 16; ++r) o2[r] = 0.f;
            const bf16_t* b2 = w2t + (size_t)(32 * wave + r32) * 256 + hi * 8;
#pragma unroll
            for (int k0 = 0; k0 < 16; ++k0) {
                const bf16x8 av = *(const bf16x8*)(hid + r32 * 264 + k0 * 16 + hi * 8);
                const bf16x8 bv = *(const GAS bf16x8*)(b2 + k0 * 16);
                o2 = __builtin_amdgcn_mfma_f32_32x32x16_bf16(av, bv, o2, 0, 0, 0);
            }
#pragma unroll
            for (int r = 0; r < 16; ++r) outf[att::crow(r, hi) * 132 + 32 * wave + r32] = o2[r];
        }
        __syncthreads();
        {
            const int grp = lane >> 4, sub = lane & 15, row = wave * 4 + grp, nn = n0 + row;
            float x[8];
#pragma unroll
            for (int e = 0; e < 8; ++e) x[e] = outf[row * 132 + sub * 8 + e];
            if (kvi == 0) {
                int tok = 16 * nn + 31; tok = tok > T - 1 ? T - 1 : tok;
                norm_rope8<128>(x, kgain, (const float*)(wsb + WS_ROPE128) + (size_t)(b * T + tok) * 32, sub);
            }
            bf16_t* dst = (bf16_t*)(wsb + (kvi ? WS_VC : WS_KC)) + ((size_t)(b * 256 + nn) * 4 + g) * 128 + sub * 8;
            st8(dst, x);
        }
    }
    __syncthreads();
}

DI void nsa_gates(int L2, char* lds, int vcu, int G, int wave, int lane) {
    unsigned char* const wsb = arg_ws();
    const int r32 = lane & 31, hi = lane >> 5, kp = wave & 1, pr = wave >> 1;
    float* part = (float*)lds + (pr & 1) * (32 * 64);
    for (int base = 0; base < M / 32; base += 2 * G) {
        const int it = base + pr * G + vcu; const bool valid = wave < 4 && it < M / 32;
        const int row0 = it * 32;
        f32x16 a0, a1;
#pragma unroll
        for (int r = 0; r < 16; ++r) { a0[r] = 0.f; a1[r] = 0.f; }
        if (valid) {
            const bf16_t* hb = (const bf16_t*)(wsb + WS_HB); const bf16_t* wg = (const bf16_t*)(wsb + WS_WG + (size_t)L2 * SZ_WG);
            const bf16_t* ap = hb + (size_t)(row0 + r32) * 256 + hi * 8;     const bf16_t* b0 = wg + (size_t)r32 * DM + hi * 8; const bf16_t* b1 = b0 + (size_t)32 * DM;
#pragma unroll 8
            for (int kk = 0; kk < DM / 32; ++kk) { const int ks = kp * (DM / 32) + kk;
                const bf16x8 av = *(const GAS bf16x8*)(ap + (size_t)(ks >> 4) * ((size_t)M * 256) + (ks & 15) * 16), bv0 = *(const GAS bf16x8*)(b0 + ks * 16), bv1 = *(const GAS bf16x8*)(b1 + ks * 16);
                a0 = __builtin_amdgcn_mfma_f32_32x32x16_bf16(av, bv0, a0, 0, 0, 0);
                a1 = __builtin_amdgcn_mfma_f32_32x32x16_bf16(av, bv1, a1, 0, 0, 0);
            }
            if (kp) {
#pragma unroll
                for (int r = 0; r < 16; ++r) { part[r * 64 + lane] = a0[r]; part[(16 + r) * 64 + lane] = a1[r]; }
            }
        } else if (wave >= 4 && base == 0) nsa_normrope(L2, vcu * 4 + wave - 4, G * 4, lane);
        __syncthreads();
        if (valid && kp == 0) {
            const float* rowss = (const float*)(wsb + WS_ROWSS); float* gates = (float*)(wsb + WS_GATES);
#pragma unroll
            for (int r = 0; r < 16; ++r) { a0[r] += part[r * 64 + lane]; a1[r] += part[(16 + r) * 64 + lane]; }
            float s = 0.f;
#pragma unroll
            for (int q = 0; q < 16; ++q) s += ((const GAS float*)rowss)[(size_t)(hi * 16 + q) * M + row0 + r32];
            s = sum_xor32(s);
            const float rs = __builtin_amdgcn_rsqf(s * (1.0f / DM) + EPS);
#pragma unroll
            for (int r = 0; r < 16; ++r) { const int row = att::crow(r, hi); const float rr = __shfl(rs, row);
                ((GAS float*)gates)[(size_t)(row0 + row) * 48 + r32] = a0[r] * rr;
                if (r32 < 16) ((GAS float*)gates)[(size_t)(row0 + row) * 48 + 32 + r32] = a1[r] * rr; }
        }
        __syncthreads();
    }
}

struct MaskCmp { int t; DI bool ok(int, int n) const { return 16 * n + 31 <= t; } DI bool partial(int) const { return true; } DI bool rowok(int) const { return true; } };
struct MaskSel { int t, qt; unsigned long long sel;
    DI bool ok(int, int key) const { return key <= t; }
    DI bool partial(int j) const { return j >= qt; }
    DI bool rowok(int j) const { return ((sel >> j) & 1ull) != 0ull; } };
struct SeqBits { unsigned long long bits; DI bool first(int& j) const { if (!bits) return false; j = __builtin_ctzll(bits); return true; }
    DI bool next(int j, int& jn) const { const unsigned long long rest = j >= 63 ? 0ull : (bits >> (j + 1)); if (!rest) return false; jn = j + 1 + __builtin_ctzll(rest); return true; } };
constexpr int NSL_KV = 0, NSL_OST = 65536, NSL_IMP = 135168, NSL_WS = 151552, NSL_SEL = 153600;
static_assert(NSL_OST + 8 * 32 * 136 * 2 <= NSL_IMP && NSL_IMP + 8 * 2048 <= NSL_WS && NSL_SEL + 512 <= MISC_OFF, "nsa LDS map");
DI void nsa_stage_out(att::Core<128>& c, bf16_t* stg, float* ws, float fac, bool first, int r32, int hi) {
    if (hi == 0) ws[r32] = fac;
    LDS_WAIT();
#pragma unroll
    for (int r = 0; r < 16; ++r) { const int orow = att::crow(r, hi); const float f = ws[orow];
#pragma unroll
        for (int d0 = 0; d0 < 4; ++d0) { bf16_t* p = stg + orow * 136 + d0 * 32 + r32; float v = c.o[d0][r] * f; if (!first) v += bf2f(*p); *p = f2bf1(v); } }
    LDS_WAIT();
}
DI void nsa_attention(int L2, char* lds, int vcu, int G, int tid, int wave, int lane) {
#define NSA_QKV ((const bf16_t*)(arg_ws() + WS_ACT))
#define NSA_KC ((const bf16_t*)(arg_ws() + WS_KC))
#define NSA_VC ((const bf16_t*)(arg_ws() + WS_VC))
    const int r32 = lane & 31, hi = lane >> 5, tl = r32 >> 2, r = r32 & 3;
    float* ws = (float*)(lds + NSL_WS) + wave * 64;
    bf16_t* stg = (bf16_t*)(lds + NSL_OST) + wave * (32 * 136);
    float* imp = (float*)(lds + NSL_IMP) + wave * 512;
    unsigned long long* selm = (unsigned long long*)(lds + NSL_SEL);
    constexpr float C = 0.088388347648318440f * 1.4426950408889634f;
    const int nper = (G == 256) ? 4 : (1024 + G - 1) / G;
    for (int ui = 0; ui < nper; ++ui) {
        int bg, qt;
        if (G == 256) { const int s = vcu & 15; bg = vcu >> 4; qt = ui == 0 ? s : (ui == 1 ? 31 - s : (ui == 2 ? 32 + s : 63 - s)); }
        else { const int u = ui * G + vcu; if (u >= 1024) break; bg = u >> 6; qt = u & 63; }
        const int b = bg >> 2, g = bg & 3, t0 = qt * 64, t = t0 + 8 * wave + tl, h = 4 * g + r;
        const bf16_t* rowp = NSA_QKV + (size_t)(b * T + t) * NS_N;
        att::Core<128> c;
        att::load_q<128>(c, rowp + h * 128, hi);
        qnorm_rope<128>(c, arg_in<15>() + L2 * 128, (const float*)(arg_ws() + WS_ROPE128) + (size_t)(b * T + t) * 32, hi);
#define NSA_GATE(k_) sigmoidf_(((const GAS float*)(arg_ws() + WS_GATES))[(size_t)(b * T + t) * 48 + h + 16 * (k_)])
        const int ncmp_tiles = (4 * qt + 3 + 63) >> 6;
        {
            att::core_reset<128>(c, att::M_INIT, 0.f);
            SeqRange seq; seq.lo = 0; seq.hi = ncmp_tiles - 1;
            MaskCmp mk; mk.t = t;
            att::run_tiles<128, false>(c, lds + NSL_KV, ws, NSA_KC + (size_t)b * 256 * 512 + g * 128, NSA_VC + (size_t)b * 256 * 512 + g * 128, 512, seq, mk, KxNone(), tid, lane);
            const bool has = (t >= 31) && c.l_reg > 0.f;
            nsa_stage_out(c, stg, ws, has ? NSA_GATE(0) * fast_rcp(c.l_reg) : 0.f, true, r32, hi);
        }
        unsigned long long mysel, usel;
        if (qt < 16) { mysel = (2ull << qt) - 1ull; usel = mysel; }
        else {
            const float inv_l = (c.l_reg > 0.f) ? fast_rcp(c.l_reg) : 0.f, mC = -c.m_reg * C;
            float carry = 0.f;
            for (int j = 0; j < ncmp_tiles; ++j) {
                att::StgH<128> s; att::stg_ld<128>(s, NSA_KC + (size_t)(b * 256 + 64 * j) * 512 + g * 128, 512, tid);
                __syncthreads();
                att::stg_wrK<128>(s, lds + NSL_KV, tid);
                __syncthreads();
                f32x16 p0, p1; att::qkt<128>(p0, p1, lds + NSL_KV, c.qr, r32, hi);
#pragma unroll
                for (int q = 0; q < 16; ++q) { const int n = 64 * j + att::crow(q, hi);
                    p0[q] = (16 * n + 31 <= t) ? fast_exp2(fmaf(p0[q], C, mC)) * inv_l : 0.f;
                    p1[q] = (16 * (n + 32) + 31 <= t) ? fast_exp2(fmaf(p1[q], C, mC)) * inv_l : 0.f; }
                float own0[4], own1[4], pl0[4], pl1[4];
#pragma unroll
                for (int q = 0; q < 4; ++q) { own0[q] = (p0[4 * q] + p0[4 * q + 1]) + (p0[4 * q + 2] + p0[4 * q + 3]); own1[q] = (p1[4 * q] + p1[4 * q + 1]) + (p1[4 * q + 2] + p1[4 * q + 3]);
                    pl0[q] = __shfl_xor(p0[4 * q + 3], 32); pl1[q] = __shfl_xor(p1[4 * q + 3], 32); }
                if (hi == 1) {
#pragma unroll
                    for (int q = 0; q < 4; ++q) { own0[q] += pl0[q]; own1[q] += pl1[q]; }
                } else {
                    own0[0] += carry; own1[0] += pl0[3];
#pragma unroll
                    for (int q = 1; q < 4; ++q) { own0[q] += pl0[q - 1]; own1[q] += pl1[q - 1]; }
                    carry = pl1[3];
                }
#pragma unroll
                for (int q = 0; q < 4; ++q) { own0[q] += __shfl_xor(own0[q], 1); own0[q] += __shfl_xor(own0[q], 2); own1[q] += __shfl_xor(own1[q], 1); own1[q] += __shfl_xor(own1[q], 2); }
                if (r == 0) {
#pragma unroll
                    for (int q = 0; q < 4; ++q) { imp[tl * 64 + 16 * j + 2 * q + hi] = own0[q]; imp[tl * 64 + 16 * j + 8 + 2 * q + hi] = own1[q]; }
                }
            }
            LDS_WAIT();
            const int tk = lane >> 3, sub = lane & 7;
            float v[8]; int cnt[8];
#pragma unroll
            for (int e = 0; e < 8; ++e) { v[e] = imp[tk * 64 + 8 * e + sub]; cnt[e] = 0; }
            for (int J2 = 1; J2 <= qt - 2; ++J2) { const float x = imp[tk * 64 + J2];
#pragma unroll
                for (int e = 0; e < 8; ++e) { const int J = 8 * e + sub; cnt[e] += (x > v[e] || (x == v[e] && J2 < J)) ? 1 : 0; } }
            unsigned long long m64 = 0ull;
#pragma unroll
            for (int e = 0; e < 8; ++e) { const int J = 8 * e + sub;
                const bool sel = (J == 0) || (J == qt) || (J == qt - 1) || (J >= 1 && J <= qt - 2 && cnt[e] < 13);
                const unsigned long long bal = __ballot(sel);
                m64 |= ((bal >> (8 * tk)) & 0xffull) << (8 * e); }
            if (sub == 0) selm[wave * 8 + tk] = m64;
            __syncthreads();
            mysel = selm[wave * 8 + tl];
            unsigned long long uu = selm[lane];
#pragma unroll
            for (int o = 1; o < 64; o <<= 1) { const unsigned lo_ = __shfl_xor((unsigned)uu, o), hi_ = __shfl_xor((unsigned)(uu >> 32), o); uu |= ((unsigned long long)hi_ << 32) | lo_; }
            usel = ((unsigned long long)__builtin_amdgcn_readfirstlane((unsigned)(uu >> 32)) << 32) | (unsigned)__builtin_amdgcn_readfirstlane((unsigned)uu);
        }
        {
            att::core_reset<128>(c, att::M_INIT, 0.f);
            SeqBits seq; seq.bits = usel;
            MaskSel mk; mk.t = t; mk.qt = qt; mk.sel = mysel;
            att::run_tiles<128, false>(c, lds + NSL_KV, ws, NSA_QKV + (size_t)b * T * NS_N + NS_KS + g * 128, NSA_QKV + (size_t)b * T * NS_N + NS_VS + g * 128, NS_N, seq, mk, KxNone(), tid, lane);
            nsa_stage_out(c, stg, ws, NSA_GATE(1) * fast_rcp(c.l_reg), false, r32, hi);
        }
        {
            att::core_reset<128>(c, att::M_INIT, 0.f);
            SeqRange seq; seq.lo = qt - 8 < 0 ? 0 : qt - 8; seq.hi = qt;
            MaskWin mk; mk.t = t; mk.w = 512; mk.tmin = t0; mk.tmax = t0 + 63;
            att::run_tiles<128, false>(c, lds + NSL_KV, ws, NSA_QKV + (size_t)b * T * NS_N + NS_KW + g * 128, NSA_QKV + (size_t)b * T * NS_N + NS_VW + g * 128, NS_N, seq, mk, KxNone(), tid, lane);
            nsa_stage_out(c, stg, ws, NSA_GATE(2) * fast_rcp(c.l_reg), false, r32, hi);
        }
#pragma unroll
        for (int i = 0; i < 8; ++i) { const int row = i * 4 + (lane >> 4), ch = lane & 15; const u32x4 v = *(const u32x4*)(stg + row * 136 + ch * 8);
            *(GAS u32x4*)((bf16_t*)(arg_ws() + WS_OB) + (size_t)(b * T + t0 + 8 * wave + (row >> 2)) * DM + (4 * g + (row & 3)) * 128 + ch * 8) = v; }
        LDS_WAIT();
        __syncthreads();
    }
}

#define GRID_BAR() do { XcdBarrier bar_; bar_.bar = (unsigned*)(arg_ws() + WS_CTL) + CW_BAR; bar_.x = xb_xcc_id(); bar_.st = (volatile LAS unsigned*)((LAS unsigned char*)lds + MISC_OFF) + 8; xcd_barrier(bar_, wave_s == 0 && lane_id_v() == 0); } while (0)
#define LIGHT_BAR() do { XcdBarrier bar_; bar_.bar = (unsigned*)(arg_ws() + WS_CTL) + CW_BAR; bar_.x = xb_xcc_id(); bar_.st = (volatile LAS unsigned*)((LAS unsigned char*)lds + MISC_OFF) + 8; if (((volatile LAS unsigned*)((LAS unsigned char*)lds + MISC_OFF))[12]) xcd_barrier_local(bar_, wave_s == 0 && lane_id_v() == 0); else xcd_barrier(bar_, wave_s == 0 && lane_id_v() == 0); } while (0)
__global__ void __launch_bounds__(NWAVES * 64, 2) fwd_kernel(Args args) {
    extern __shared__ __attribute__((aligned(16))) unsigned char lds[];
    LAS unsigned char* ldsl = (LAS unsigned char*)lds;
    const int wave_s = __builtin_amdgcn_readfirstlane((int)threadIdx.x >> 6);
    {
        const int tid = threadIdx.x;
        volatile LAS unsigned* MISC = (volatile LAS unsigned*)(ldsl + MISC_OFF);
        for (int u = tid; u < (LDS_BYTES - MISC_OFF) / 4; u += NWAVES * 64) MISC[u] = 0u;
        __syncthreads();
        (void)xcd_barrier_post((unsigned*)(arg_ws() + WS_CTL) + CW_BAR, MISC + 8);
        { int bxs = blockIdx.x; asm volatile("" : "+s"(bxs)); if (tid == 0) __hip_atomic_store((unsigned*)(arg_ws() + WS_CTL + 8192) + bxs, xb_xcc_id() + 1u, __ATOMIC_RELAXED, __HIP_MEMORY_SCOPE_AGENT); }
    }
#define TIDV int tid_ = wave_s * 64 + lane_id_v(); asm volatile("" : "+v"(tid_)); int G_ = gridDim.x, bx_ = blockIdx.x; asm volatile("" : "+s"(G_), "+s"(bx_)); const int tid = tid_, lane = tid & 63, wave = __builtin_amdgcn_readfirstlane(tid >> 6); const int G = G_, bx = bx_, vcu = (G % 8 == 0) ? (bx % 8) * (G / 8) + bx / 8 : bx; (void)tid; (void)lane; (void)wave; (void)vcu
#ifndef NO_PRO
    { TIDV; prologue(ldsl, vcu, G, wave, lane); }
#endif
    GRID_BAR();
    {
        unsigned* xt = (unsigned*)(arg_ws() + WS_CTL + 8192);
        int G = gridDim.x; asm volatile("" : "+s"(G)); int ok = (G % 8 == 0) ? 1 : 0;
        const int t_ = wave_s * 64 + lane_id_v();
        for (int b = t_; b < G; b += NWAVES * 64) { const unsigned e = xb_ld(&xt[b]), e0 = xb_ld(&xt[b & 7]); ok &= (e == e0 && e != 0u) ? 1 : 0; }
        {
            volatile LAS unsigned* MISC = (volatile LAS unsigned*)(ldsl + MISC_OFF);
            const unsigned wok = __all(ok) ? 1u : 0u;
            if (lane_id_v() == 0) MISC[16 + wave_s] = wok;
            __syncthreads();
            if (t_ == 0) { unsigned a = 1u; for (int w = 0; w < NWAVES; ++w) a &= MISC[16 + w]; MISC[12] = a; }
            __syncthreads();
        }
    }

    int stage = 0;
    for (int hl = 0; hl < 2 * DEPTH; ++hl) {
        if (stage < NSTAGES) {
#ifndef NO_S1
            {
                unsigned char* ws = arg_ws();
                pg8::Gemm g{(const bf16_t*)(ws + WS_HB), (const bf16_t*)(ws + WS_WFI + (size_t)hl * SZ_WFI), M, NFF, DM};
                pg8::StaticOrder S; { int G_ = gridDim.x, bx_ = blockIdx.x; asm volatile("" : "+s"(G_), "+s"(bx_)); S.init(M, NFF, G_, bx_); }
                pg8::cached_rs_reset(wave_s);
                pg8::EpiSwiGLU E{(bf16_t*)(ws + WS_ACT), (const float*)(ws + WS_ROWSS)};
                pg8::gemm_phase<pg8::EpiSwiGLU, pg8::StaticOrder, DM, true, true, true>(ldsl, g, S, E, wave_s);
            }
#endif
            GRID_BAR();
#ifndef NO_S2
            {
                unsigned char* ws = arg_ws(); float* out = (stage == 3 * DEPTH - 1) ? arg_out() : nullptr;
                pg8::Gemm g{(const bf16_t*)(ws + WS_ACT), (const bf16_t*)(ws + WS_WFO + (size_t)hl * SZ_WFO), M, DM, DFF};
                pg8::StaticOrder S; { int G_ = gridDim.x, bx_ = blockIdx.x; asm volatile("" : "+s"(G_), "+s"(bx_)); S.init(M, DM, G_, bx_); }
                pg8::EpiResid E{(bf16_t*)(ws + WS_HB), (bf16_t*)(ws + WS_LB), out, (float*)(ws + WS_ROWSS), 0.5f};
                pg8::gemm_phase<pg8::EpiResid, pg8::StaticOrder, DFF, false, true>(ldsl, g, S, E, wave_s);
            }
#endif
            GRID_BAR();
        }
        ++stage;
        if ((hl & 1) == 0) {
            if (stage < NSTAGES) {
                const int L = hl >> 1, L2 = L >> 1; const bool swa = (L & 1) == 0;
#ifndef NO_S3
                {
                    unsigned char* ws = arg_ws();
                    const int N = swa ? SW_N : NS_N;
                    pg8::Gemm g{(const bf16_t*)(ws + WS_HB), (const bf16_t*)(swa ? ws + WS_WSI + (size_t)L2 * SZ_WSI : ws + WS_WNI + (size_t)L2 * SZ_WNI), M, N, DM};
                    pg8::StaticOrder S; { int G_ = gridDim.x, bx_ = blockIdx.x; asm volatile("" : "+s"(G_), "+s"(bx_)); S.init(M, N, G_, bx_); }
                    pg8::cached_rs_reset(wave_s);
                    pg8::EpiScaleBf16 E{(bf16_t*)(ws + WS_ACT), N, (const float*)(ws + WS_ROWSS)};
                    pg8::gemm_phase<pg8::EpiScaleBf16, pg8::StaticOrder, DM, true, true, true>(ldsl, g, S, E, wave_s);
                }
                if (swa) { TIDV;
                    const int nun = (M / 256) * (SW_N / 256), maxu = (nun + G - 1) / G, b0 = nun - (maxu - 1) * G;
                    if (b0 >= G) convert_deferred(ldsl, L2, bx, G, wave, lane);
                    else if (bx >= b0) convert_deferred(ldsl, L2, bx - b0, G - b0, wave, lane);
                }
#endif
                GRID_BAR();
                if (swa) {
#ifndef NO_SWA
                    { TIDV; swa_attention(L2, (char*)lds, vcu, G, tid, wave, lane); }
#endif
                } else {
#ifndef NO_NSAC
                    { TIDV; nsa_compress(L2, (char*)lds, vcu, G, tid, wave, lane);
                      nsa_gates(L2, (char*)lds, vcu, G, wave, lane); }
#endif
                    GRID_BAR();
#ifndef NO_NSAA
                    { TIDV; nsa_attention(L2, (char*)lds, vcu, G, tid, wave, lane); }
#endif
                }
                GRID_BAR();
#ifndef NO_S4
                {
                    unsigned char* ws = arg_ws();
                    pg8::Gemm g{(const bf16_t*)(ws + WS_OB), (const bf16_t*)(swa ? ws + WS_WSO + (size_t)L2 * SZ_WO : ws + WS_WNO + (size_t)L2 * SZ_WO), M, DM, DM};
                    pg8::StaticOrder S; { int G_ = gridDim.x, bx_ = blockIdx.x; asm volatile("" : "+s"(G_), "+s"(bx_)); S.init(M, DM, G_, bx_); }
                    pg8::EpiResid E{(bf16_t*)(ws + WS_HB), (bf16_t*)(ws + WS_LB), nullptr, (float*)(ws + WS_ROWSS), 1.0f};
                    pg8::gemm_phase<pg8::EpiResid, pg8::StaticOrder, DM, false, true>(ldsl, g, S, E, wave_s);
                }
#endif
                GRID_BAR();
            }
            ++stage;
        }
    }
    (void)args;
}

extern "C" void kernel_launch(void* const* d_in, const int* in_sizes, int n_in, void* d_out, int out_size, void* d_ws, size_t ws_size, hipStream_t stream) {
    static int grid = 0;
    if (grid == 0) {
        if (n_in != 24 || in_sizes[0] != M * DM || out_size != M * DM || ws_size < WS_END) {
            fprintf(stderr, "kernel_launch: shape mismatch n_in %d in0 %d out %d ws %zu (need %zu)\n", n_in, n_in > 0 ? in_sizes[0] : -1, out_size, ws_size, (size_t)WS_END); grid = -1; return; }
        int dev = 0, cus = 0;
        if (hipGetDevice(&dev) != hipSuccess || hipDeviceGetAttribute(&cus, hipDeviceAttributeMultiprocessorCount, dev) != hipSuccess) { grid = -1; return; }
        if (hipFuncSetAttribute((const void*)fwd_kernel, hipFuncAttributeMaxDynamicSharedMemorySize, LDS_BYTES) != hipSuccess) { fprintf(stderr, "kernel_launch: hipFuncSetAttribute failed\n"); grid = -1; return; }
        int per_cu = 0;
        if (hipOccupancyMaxActiveBlocksPerMultiprocessor(&per_cu, (const void*)fwd_kernel, NWAVES * 64, LDS_BYTES) != hipSuccess || per_cu < 1) {
            fprintf(stderr, "kernel_launch: occupancy query reports %d workgroups per CU\n", per_cu); }
        (void)hipGetLastError();
        grid = cus;
    }
    if (grid < 0) return;
    if (hipMemsetAsync((char*)d_ws + WS_CTL, 0, CTL_ZERO_BYTES, stream) != hipSuccess) return;
    Args a{};
    for (int i = 0; i < 24; ++i) a.in[i] = (const float*)d_in[i];
    a.out = (float*)d_out; a.ws = (unsigned char*)d_ws;
    hipLaunchKernelGGL(fwd_kernel, dim3(grid), dim3(NWAVES * 64), LDS_BYTES, stream, a);
    const hipError_t le = hipPeekAtLastError();
    if (le != hipSuccess) fprintf(stderr, "kernel_launch: launch failed: %s\n", hipGetErrorName(le));
}
```
